# Optimizing an MI355X kernel written in HIP

```python
import math
import jax
import jax.numpy as jnp
from jax import lax
import numpy as np

D_MODEL = 1024
BATCH = 32
SEQ = 2048
DEPTH = 4

GRID_W = 64
CTX_LEN = 256
N_MIXERS = 3
EXPAND = 2
E_WIDTH = EXPAND * D_MODEL
HEAD_DIM = 128
N_Q_HEADS = E_WIDTH // HEAD_DIM
N_KV_HEADS = max(1, N_Q_HEADS // 4)
Q_PER_KV = N_Q_HEADS // N_KV_HEADS
KV_WIDTH = N_KV_HEADS * HEAD_DIM
WINDOW = 128
ATTN_BLOCK = 128
ROPE_THETA = 10000.0
S5_GROUP = 16
S5_GROUPS = E_WIDTH // S5_GROUP
S5_STATE = 64
S5_CHUNK = 128
HG_HEAD_DIM = 128
HG_HEADS = E_WIDTH // HG_HEAD_DIM
HG_CHUNK = 64
ATTN_IN = 2 * E_WIDTH + 2 * KV_WIDTH
S5_IN = 2 * E_WIDTH
HG_IN = 5 * E_WIDTH
NORM_EPS = 1e-5
NEG_INF = -1e30

kernel_name = 'hybrid_diffusion_gqa_s5_hgrn2'


def layer_norm(x, g, b):
    xf = x.astype(jnp.float32)
    mu = jnp.mean(xf, -1, keepdims=True)
    var = jnp.mean(jnp.square(xf - mu), -1, keepdims=True)
    y = (xf - mu) * lax.rsqrt(var + NORM_EPS) * g.astype(jnp.float32) + b.astype(jnp.float32)
    return y.astype(x.dtype)


def grid_positions(n_tokens):
    rows = n_tokens // GRID_W
    row = jnp.repeat(jnp.arange(rows, dtype=jnp.float32), GRID_W)
    col = jnp.tile(jnp.arange(GRID_W, dtype=jnp.float32), rows)
    return row, col


def rope_2d(x, row, col):
    half = x.shape[-1] // 2
    nf = half // 2
    inv_freq = jnp.power(ROPE_THETA, -jnp.arange(nf, dtype=jnp.float32) / nf)
    xf = x.astype(jnp.float32)

    def rotate(xp, pos):
        ang = pos[:, None] * inv_freq[None, :]
        cos = jnp.cos(ang)[None, :, None, :]
        sin = jnp.sin(ang)[None, :, None, :]
        x1, x2 = xp[..., :nf], xp[..., nf:]
        return jnp.concatenate([x1 * cos - x2 * sin, x2 * cos + x1 * sin], -1)

    return jnp.concatenate([rotate(xf[..., :half], row), rotate(xf[..., half:], col)], -1).astype(x.dtype)


def softmax_with_sink(s, sink):
    sk = jnp.broadcast_to(sink[None, :, :, None, None], s.shape[:-1] + (1,))
    return jax.nn.softmax(jnp.concatenate([s, sk], -1), axis=-1)[..., :-1]


def attention_mixer(p, pc, sink, row, col, ctx_out):
    bsz, n_lat, _ = p.shape
    n_ctx = pc.shape[1]

    def split(t):
        b_, l_ = t.shape[0], t.shape[1]
        q = t[..., :E_WIDTH].reshape(b_, l_, N_Q_HEADS, HEAD_DIM)
        k = t[..., E_WIDTH:E_WIDTH + KV_WIDTH].reshape(b_, l_, N_KV_HEADS, HEAD_DIM)
        v = t[..., E_WIDTH + KV_WIDTH:].reshape(b_, l_, N_KV_HEADS, HEAD_DIM)
        return q, k, v

    q, k, v = split(p)
    qc, kc, vc = split(pc)
    q = rope_2d(q, row, col).reshape(bsz, n_lat, N_KV_HEADS, Q_PER_KV, HEAD_DIM)
    k = rope_2d(k, row, col)
    qc = qc.reshape(bsz, n_ctx, N_KV_HEADS, Q_PER_KV, HEAD_DIM)
    scale = HEAD_DIM ** -0.5
    sink_r = sink.astype(jnp.float32).reshape(N_KV_HEADS, Q_PER_KV)

    n_blk = n_lat // ATTN_BLOCK
    n_key = ATTN_BLOCK + 2 * WINDOW
    qb = q.reshape(bsz, n_blk, ATTN_BLOCK, N_KV_HEADS, Q_PER_KV, HEAD_DIM).swapaxes(0, 1)
    pad = ((0, 0), (WINDOW, WINDOW), (0, 0), (0, 0))
    kp = jnp.pad(k, pad)
    vp = jnp.pad(v, pad)
    q_off = jnp.arange(ATTN_BLOCK)
    k_off = jnp.arange(n_key) - WINDOW

    def block(args):
        j, qj = args
        start = j * ATTN_BLOCK
        kj = lax.dynamic_slice_in_dim(kp, start, n_key, axis=1)
        vj = lax.dynamic_slice_in_dim(vp, start, n_key, axis=1)
        qpos = start + q_off
        kpos = start + k_off
        valid = ((jnp.abs(qpos[:, None] - kpos[None, :]) <= WINDOW)
                 & (kpos >= 0)[None, :] & (kpos < n_lat)[None, :])
        s_win = jnp.einsum('bqhgd,bkhd->bhgqk', qj, kj, preferred_element_type=jnp.float32) * scale
        s_win = jnp.where(valid, s_win, NEG_INF)
        s_ctx = jnp.einsum('bqhgd,bchd->bhgqc', qj, kc, preferred_element_type=jnp.float32) * scale
        pr = softmax_with_sink(jnp.concatenate([s_win, s_ctx], -1), sink_r).astype(vj.dtype)
        return (jnp.einsum('bhgqk,bkhd->bqhgd', pr[..., :n_key], vj)
                + jnp.einsum('bhgqc,bchd->bqhgd', pr[..., n_key:], vc))

    o = lax.map(block, (jnp.arange(n_blk), qb)).swapaxes(0, 1).reshape(bsz, n_lat, E_WIDTH)
    if not ctx_out:
        return o, None
    sc = jnp.einsum('bqhgd,bkhd->bhgqk', qc, kc, preferred_element_type=jnp.float32) * scale
    prc = softmax_with_sink(sc, sink_r).astype(vc.dtype)
    oc = jnp.einsum('bhgqk,bkhd->bqhgd', prc, vc).reshape(bsz, n_ctx, E_WIDTH)
    return o, oc


def flip_seq(t, rev):
    return jnp.flip(t, axis=1) if rev else t


def _linrec_combine(e1, e2):
    a1, b1 = e1
    a2, b2 = e2
    return a1 * a2, a2 * b1 + b2


def s5_discretise(lam_re, lam_im, log_step, b_re, b_im, c_re, c_im):
    lam = lax.complex(lam_re.astype(jnp.float32), lam_im.astype(jnp.float32))
    dt = jnp.exp(log_step.astype(jnp.float32))[:, None]
    abar = jnp.exp(lam * dt)
    bmat = lax.complex(b_re.astype(jnp.float32), b_im.astype(jnp.float32))
    bbar = ((abar - 1.0) / lam)[..., None] * bmat
    cmat = lax.complex(c_re.astype(jnp.float32), c_im.astype(jnp.float32))
    return abar, bbar, cmat


def s5_scan(u, abar, bbar, cmat, h0):
    bsz, n_tok, n_g, n_c = u.shape
    n_chunk = n_tok // S5_CHUNK
    uc = u.reshape(bsz, n_chunk, S5_CHUNK, n_g, n_c).swapaxes(0, 1)

    def step(h, u_blk):
        bu = jnp.einsum('btgn,gpn->btgp', u_blk.astype(jnp.complex64), bbar)
        bu = bu.at[:, 0].add(abar[None] * h)
        a = jnp.broadcast_to(abar, bu.shape)
        _, hs = lax.associative_scan(_linrec_combine, (a, bu), axis=1)
        y = jnp.einsum('btgp,gnp->btgn', hs, cmat).real
        return hs[:, -1], y

    h_last, ys = lax.scan(step, h0, uc)
    return ys.swapaxes(0, 1).reshape(bsz, n_tok, n_g, n_c), h_last


def s5_mixer(p, pc, lam_re, lam_im, log_step, b_re, b_im, c_re, c_im, d_skip, glu_w, glu_b):
    bsz, n_lat, _ = p.shape
    n_ctx = pc.shape[1]
    u = p.astype(jnp.float32).reshape(bsz, n_lat, S5_GROUPS, S5_GROUP)
    uc = pc.astype(jnp.float32).reshape(bsz, n_ctx, S5_GROUPS, S5_GROUP)
    d = d_skip.astype(jnp.float32).reshape(S5_GROUPS, S5_GROUP)
    y = d * u
    yc = d * uc
    for rev in (0, 1):
        abar, bbar, cmat = s5_discretise(lam_re[rev], lam_im[rev], log_step[rev],
                                         b_re[rev], b_im[rev], c_re[rev], c_im[rev])
        h0 = jnp.zeros((bsz, S5_GROUPS, S5_STATE), jnp.complex64)
        yc_dir, h_ctx = s5_scan(flip_seq(uc, rev), abar, bbar, cmat, h0)
        y_dir, _ = s5_scan(flip_seq(u, rev), abar, bbar, cmat, h_ctx)
        y = y + flip_seq(y_dir, rev)
        yc = yc + flip_seq(yc_dir, rev)
    w = glu_w.astype(jnp.float32)
    bias = glu_b.astype(jnp.float32)

    def glu(t, n):
        g = jax.nn.gelu(t.reshape(bsz, n, E_WIDTH))
        return (g * jax.nn.sigmoid(g @ w + bias)).astype(p.dtype)

    return glu(y, n_lat), glu(yc, n_ctx)


def hgrn2_scan(q, k, v, logf, s0):
    bsz, n_tok, n_h, _ = q.shape
    n_chunk = n_tok // HG_CHUNK
    mid = HG_CHUNK // 2
    order_mask = jnp.tril(jnp.ones((HG_CHUNK, HG_CHUNK), dtype=bool))

    def blocks(t):
        return t.reshape(bsz, n_chunk, HG_CHUNK, n_h, t.shape[-1]).transpose(1, 0, 3, 2, 4)

    def step(s, blk):
        qb, kb, vb, gb = blk
        b = jnp.cumsum(gb, axis=2)
        ref = b[:, :, mid:mid + 1]
        att = jnp.einsum('bhtk,bhsk->bhts', qb * jnp.exp(b - ref), kb * jnp.exp(ref - b))
        att = jnp.where(order_mask, att, 0.0)
        o = (jnp.einsum('bhts,bhsv->bhtv', att, vb)
             + jnp.einsum('bhtk,bhkv->bhtv', qb * jnp.exp(b), s))
        b_last = b[:, :, -1:]
        s = (jnp.exp(b_last[:, :, 0])[..., None] * s
             + jnp.einsum('bhsk,bhsv->bhkv', kb * jnp.exp(b_last - b), vb))
        return s, o

    s_last, outs = lax.scan(step, s0, (blocks(q), blocks(k), blocks(v), blocks(logf)))
    return outs.transpose(1, 0, 3, 2, 4).reshape(bsz, n_tok, n_h, v.shape[-1]), s_last


def hgrn2_mixer(p, pc, lb, norm_g):
    bsz, n_lat, _ = p.shape
    n_ctx = pc.shape[1]
    lbh = lb.astype(jnp.float32).reshape(HG_HEADS, HG_HEAD_DIM)

    def heads(t):
        t = t.astype(jnp.float32).reshape(t.shape[0], t.shape[1], 4, HG_HEADS, HG_HEAD_DIM)
        return t[:, :, 0], t[:, :, 1], t[:, :, 2], t[:, :, 3]

    q, f_fw, f_bw, v = heads(p)
    qc, fc_fw, fc_bw, vc = heads(pc)
    outs, outs_c = [], []
    for rev, (fl, flc) in enumerate(((f_fw, fc_fw), (f_bw, fc_bw))):
        f = lbh + (1.0 - lbh) * jax.nn.sigmoid(fl)
        fc = lbh + (1.0 - lbh) * jax.nn.sigmoid(flc)
        s0 = jnp.zeros((bsz, HG_HEADS, HG_HEAD_DIM, HG_HEAD_DIM), jnp.float32)
        oc_dir, s_ctx = hgrn2_scan(flip_seq(qc, rev), flip_seq(1.0 - fc, rev),
                                   flip_seq(vc, rev), flip_seq(jnp.log(fc), rev), s0)
        o_dir, _ = hgrn2_scan(flip_seq(q, rev), flip_seq(1.0 - f, rev),
                              flip_seq(v, rev), flip_seq(jnp.log(f), rev), s_ctx)
        outs.append(flip_seq(o_dir, rev))
        outs_c.append(flip_seq(oc_dir, rev))
    g = norm_g.astype(jnp.float32).reshape(HG_HEADS, HG_HEAD_DIM)

    def head_norm(t, n):
        t = t * lax.rsqrt(jnp.mean(jnp.square(t), -1, keepdims=True) + NORM_EPS) * g
        return t.reshape(bsz, n, E_WIDTH).astype(p.dtype)

    return head_norm(outs[0] + outs[1], n_lat), head_norm(outs_c[0] + outs_c[1], n_ctx)


def setup_inputs(seed: int = 0) -> dict:
    key = jax.random.key(seed)
    ks = jax.random.split(key, 25)
    f32 = jnp.float32
    n_attn = len(range(0, DEPTH, N_MIXERS))
    n_s5 = len(range(1, DEPTH, N_MIXERS))
    n_hg = len(range(2, DEPTH, N_MIXERS))
    beta = (8.0 * DEPTH) ** -0.25

    def nrm(k, shape, std):
        return std * jax.random.normal(k, shape, f32)

    s5_shape = (n_s5, 2, S5_GROUPS, S5_STATE)
    lam_im_init = math.pi * jnp.arange(S5_STATE, dtype=f32)
    return {
        'x': nrm(ks[0], (BATCH, SEQ, D_MODEL), 1.0),
        'c': nrm(ks[1], (BATCH, D_MODEL), 1.0),
        'ctx': nrm(ks[2], (BATCH, CTX_LEN, D_MODEL), 1.0),
        'c_ctx': nrm(ks[3], (D_MODEL,), 1.0),
        'ada_w': nrm(ks[4], (DEPTH, D_MODEL, 3 * D_MODEL), 0.5 * D_MODEL ** -0.5),
        'ada_b': nrm(ks[5], (DEPTH, 3 * D_MODEL), 0.02),
        'ln_g': 1.0 + nrm(ks[6], (DEPTH, D_MODEL), 0.02),
        'ln_b': nrm(ks[7], (DEPTH, D_MODEL), 0.02),
        'w_out': nrm(ks[8], (DEPTH, E_WIDTH, D_MODEL), beta * E_WIDTH ** -0.5),
        'attn_w_in': nrm(ks[9], (n_attn, D_MODEL, ATTN_IN), D_MODEL ** -0.5),
        'attn_sink': nrm(ks[10], (n_attn, N_Q_HEADS), 0.5),
        's5_w_in': nrm(ks[11], (n_s5, D_MODEL, S5_IN), D_MODEL ** -0.5),
        's5_lam_re': -0.5 + nrm(ks[12], s5_shape, 0.01),
        's5_lam_im': lam_im_init + nrm(ks[13], s5_shape, 0.01),
        's5_log_step': jax.random.uniform(ks[14], (n_s5, 2, S5_GROUPS), f32, math.log(1e-3), math.log(1e-1)),
        's5_b_re': nrm(ks[15], (n_s5, 2, S5_GROUPS, S5_STATE, S5_GROUP), (2 * S5_GROUP) ** -0.5),
        's5_b_im': nrm(ks[16], (n_s5, 2, S5_GROUPS, S5_STATE, S5_GROUP), (2 * S5_GROUP) ** -0.5),
        's5_c_re': nrm(ks[17], (n_s5, 2, S5_GROUPS, S5_GROUP, S5_STATE), S5_STATE ** -0.5),
        's5_c_im': nrm(ks[18], (n_s5, 2, S5_GROUPS, S5_GROUP, S5_STATE), S5_STATE ** -0.5),
        's5_d': nrm(ks[19], (n_s5, E_WIDTH), 0.5),
        's5_glu_w': nrm(ks[20], (n_s5, E_WIDTH, E_WIDTH), E_WIDTH ** -0.5),
        's5_glu_b': nrm(ks[21], (n_s5, E_WIDTH), 0.02),
        'hg_w_in': nrm(ks[22], (n_hg, D_MODEL, HG_IN), D_MODEL ** -0.5),
        'hg_lb': nrm(ks[23], (DEPTH, E_WIDTH), 0.1),
        'hg_norm_g': 1.0 + nrm(ks[24], (n_hg, E_WIDTH), 0.02),
    }


def reference(x, c, ctx, c_ctx, ada_w, ada_b, ln_g, ln_b, w_out, attn_w_in, attn_sink,
              s5_w_in, s5_lam_re, s5_lam_im, s5_log_step, s5_b_re, s5_b_im, s5_c_re, s5_c_im,
              s5_d, s5_glu_w, s5_glu_b, hg_w_in, hg_lb, hg_norm_g):
    n_lat = x.shape[1]
    row, col = grid_positions(n_lat)
    alpha = (2.0 * DEPTH) ** 0.25
    lb_w = jax.nn.softmax(hg_lb.astype(jnp.float32), axis=0)
    lb_all = jnp.cumsum(lb_w, axis=0) - lb_w[0:1]
    xc = ctx
    for i in range(DEPTH):
        kind, j = i % N_MIXERS, i // N_MIXERS
        last = i == DEPTH - 1
        mod = jax.nn.silu(c) @ ada_w[i] + ada_b[i]
        mod_c = jax.nn.silu(c_ctx) @ ada_w[i] + ada_b[i]
        shift, scale, gate = jnp.split(mod[:, None, :], 3, axis=-1)
        shift_c, scale_c, gate_c = jnp.split(mod_c, 3, axis=-1)
        h = x * (1.0 + scale) + shift
        hc = xc * (1.0 + scale_c) + shift_c
        w_in = (attn_w_in, s5_w_in, hg_w_in)[kind][j]
        pz = h @ w_in
        pzc = hc @ w_in
        p, z = pz[..., :-E_WIDTH], pz[..., -E_WIDTH:]
        pc, zc = pzc[..., :-E_WIDTH], pzc[..., -E_WIDTH:]
        if kind == 0:
            y, yc = attention_mixer(p, pc, attn_sink[j], row, col, not last)
        elif kind == 1:
            y, yc = s5_mixer(p, pc, s5_lam_re[j], s5_lam_im[j], s5_log_step[j], s5_b_re[j], s5_b_im[j],
                             s5_c_re[j], s5_c_im[j], s5_d[j], s5_glu_w[j], s5_glu_b[j])
        else:
            y, yc = hgrn2_mixer(p, pc, lb_all[i], hg_norm_g[j])
        x = layer_norm(alpha * x + gate * ((y * jax.nn.silu(z)) @ w_out[i]), ln_g[i], ln_b[i])
        if not last:
            xc = layer_norm(alpha * xc + gate_c * ((yc * jax.nn.silu(zc)) @ w_out[i]), ln_g[i], ln_b[i])
    return x
```

```cpp
#include <hip/hip_runtime.h>
#include <hip/hip_cooperative_groups.h>
#include <cstdio>
namespace cg = cooperative_groups;

#define DI __device__ __forceinline__
#define LAS __attribute__((address_space(3)))
typedef unsigned short bf16_t;
typedef short bf16x8 __attribute__((ext_vector_type(8)));
typedef float f32x2 __attribute__((ext_vector_type(2)));
typedef float f32x4 __attribute__((ext_vector_type(4)));
typedef float f32x16 __attribute__((ext_vector_type(16)));
typedef unsigned u32x2 __attribute__((ext_vector_type(2)));
typedef unsigned u32x4 __attribute__((ext_vector_type(4)));
typedef __bf16 bfv2 __attribute__((ext_vector_type(2)));
typedef short s16x4 __attribute__((ext_vector_type(4)));
#define LDS_TR16(ptr) __builtin_amdgcn_ds_read_tr16_b64_v4i16((LAS s16x4*)(ptr))

constexpr int D = 1024, E = 2048, TPB = 2304, NB = 8, CHR = NB * TPB, NCHUNK = 4;
constexpr int IN_X = 0, IN_C = 1, IN_CTX = 2, IN_CCTX = 3, IN_ADAW = 4, IN_ADAB = 5, IN_LNG = 6, IN_LNB = 7, IN_WOUT = 8, IN_ATTW = 9, IN_SINK = 10,
              IN_S5W = 11, IN_LRE = 12, IN_LIM = 13, IN_LSTEP = 14, IN_BRE = 15, IN_BIM = 16, IN_CRE = 17, IN_CIM = 18, IN_S5D = 19, IN_GLUW = 20,
              IN_GLUB = 21, IN_HGW = 22, IN_HGLB = 23, IN_HGNG = 24;
constexpr size_t OFF_WT_ATT = 0;
constexpr size_t OFF_WT_S5 = OFF_WT_ATT + 2ull * 5120 * 1024 * 2;
constexpr size_t OFF_WT_HG = OFF_WT_S5 + 4096ull * 1024 * 2;
constexpr size_t OFF_WT_OUT = OFF_WT_HG + 10240ull * 1024 * 2;
constexpr size_t OFF_WT_GLU = OFF_WT_OUT + 4ull * 1024 * 2048 * 2;
constexpr size_t OFF_MODS = OFF_WT_GLU + 2048ull * 2048 * 2;
constexpr size_t OFF_ROPE = OFF_MODS + 2097152;
constexpr size_t OFF_XCTX = OFF_ROPE + 65536;
constexpr size_t OFF_H = OFF_XCTX + 8192ull * 1024 * 4;
constexpr size_t OFF_BT1 = OFF_H + 73728ull * 1024 * 2;
constexpr size_t OFF_BT3 = OFF_BT1 + 128ull * 256 * 256 * 2;
constexpr size_t OFF_AOUT = OFF_BT3 + 128ull * 256 * 512 * 2;
constexpr size_t OFF_PZ = OFF_AOUT + 2 * (size_t)CHR * 2048 * 2;
constexpr size_t OFF_UH = OFF_PZ + (size_t)CHR * 4096 * 2;
constexpr size_t OFF_OB = OFF_PZ + (size_t)CHR * 10240 * 2;
constexpr size_t OFF_HLOC = OFF_UH + 128ull * 1280 * 512 * 2;
constexpr size_t OFF_BAR = OFF_HLOC + 128ull * 1280 * 256 * 4;
constexpr size_t WS_END = OFF_BAR + 16384;
static_assert(OFF_OB + (size_t)CHR * 2048 * 2 <= OFF_BAR && OFF_PZ + 2 * (size_t)CHR * 5120 * 2 <= OFF_BAR, "ws");
constexpr int LDS_BYTES = 160 * 1024;

struct Params { const float* in[25]; float* out; unsigned char* ws; };
typedef const __attribute__((address_space(4))) Params& PRef;

DI unsigned pk2(float a, float b) { f32x2 v = {a, b}; bfv2 r = __builtin_convertvector(v, bfv2); return __builtin_bit_cast(unsigned, r); }
DI float bflo(unsigned u) { return __uint_as_float(u << 16); }
DI float bfhi(unsigned u) { return __uint_as_float(u & 0xffff0000u); }
DI float bf2f(bf16_t u) { return __uint_as_float(((unsigned)u) << 16); }
DI float sigmoidf_(float v) { return __builtin_amdgcn_rcpf(1.0f + __expf(-v)); }
DI float siluf_(float v) { return v * sigmoidf_(v); }
DI float gelu_tanh(float x) { return x * sigmoidf_(1.5957691216f * (x + 0.044715f * x * x * x)); }
DI float glu_gate(float g, float u, float z) { return g * z * __builtin_amdgcn_rcpf((1.0f + __expf(-u)) * (1.0f + __expf(-z))); }
DI float xhalf_max(float v) { const auto r = __builtin_amdgcn_permlane32_swap(__float_as_uint(v), __float_as_uint(v), false, false); return fmaxf(__uint_as_float(r[0]), __uint_as_float(r[1])); }
DI float xhalf_sum(float v) { const auto r = __builtin_amdgcn_permlane32_swap(__float_as_uint(v), __float_as_uint(v), false, false); return __uint_as_float(r[0]) + __uint_as_float(r[1]); }
DI int opaque_tid() { int t = threadIdx.x; asm volatile("" : "+v"(t)); return t; }
DI int crow(int reg, int h) { return (reg & 3) + 8 * (reg >> 2) + 4 * h; }
#define MFMA32(a, b, c) __builtin_amdgcn_mfma_f32_32x32x16_bf16((a), (b), (c), 0, 0, 0)

namespace pg8 {
constexpr int BM = 256, BK = 64, HALF = 128, HTB = HALF * BK * 2, STAGE_BYTES = 8 * HTB, NXCD = 8, WGM = 8;
DI int lds_byte(int r, int c) { const int st = (r >> 4) * 2 + (c >> 5), rr = r & 15, cc = c & 31, ob = rr * 64 + cc * 2; return st * 1024 + (ob ^ (((ob >> 9) & 1) << 5)); }
DI void stage_rc(int b, int& R, int& C) { const int st = b / 1024, sb = b % 1024, swz = sb ^ (((sb >> 9) & 1) << 5); R = (st >> 1) * 16 + swz / 64; C = (st & 1) * 32 + (swz % 64) / 2; }
DI int perm32(int rho) { const int n = rho >> 4, i = rho & 15; return 8 * (i >> 2) + 4 * n + (i & 3); }
struct Unit { int pm, pn, z; };
struct Gemm { const bf16_t* A; const bf16_t* Bt; int lda, ldb, K; long zsA, zsB; };
struct Sched {
    int nM, nN, per, total, G, c, skipctx, R, rem, pn0 = 0;
    DI void init(int nM_, int nN_, int nZ_, int G_, int c_, int skipctx_, int R_ = 0x3fffffff, int rem_ = 0) { nM = nM_; nN = nN_; per = nM_ * nN_; total = per * nZ_; G = G_; c = c_; skipctx = skipctx_; R = R_; rem = rem_; pn0 = 0; }
    DI bool next(int i, Unit& u) const {
        if (c < 0) return false;
        long L;
        if (i < R || rem == 0) L = (long)i * G + c;
        else { if (c < rem) return false; L = (long)R * G + (long)(i - R) * (G - rem) + (c - rem); }
        if (L >= total) return false;
        const int z = (int)(L / per); int wgid = (int)(L % per); const int nwg = per;
        { const int q = nwg / NXCD, r = nwg % NXCD, xcd = wgid % NXCD, off = wgid / NXCD; wgid = (xcd < r ? xcd * (q + 1) : r * (q + 1) + (xcd - r) * q) + off; }
        const int nig = WGM * nN, gid = wgid / nig, fm = gid * WGM, gsz = (nM - fm) < WGM ? (nM - fm) : WGM;
        int pm = fm + ((wgid % nig) % gsz); const int pn = (wgid % nig) / gsz;
        if (skipctx == 1) pm = (pm >> 3) * 9 + 1 + (pm & 7); else if (skipctx == 2) pm = pm * 9;
        u.pm = pm; u.pn = pn + pn0; u.z = z; return true;
    }
};

template <class Epi>
DI void gemm_phase(LAS unsigned char* lds, const Gemm g, const Sched& S, const Epi& E) {
    const int tid = opaque_tid(), wid = __builtin_amdgcn_readfirstlane(tid >> 6), lane = tid & 63, wr = wid >> 2, wc = wid & 3, fr = lane & 15, fq = lane >> 4;
    const int K = g.K, nt = K / BK;
    unsigned voffA[2], voffB[2];
#pragma unroll
    for (int i = 0; i < 2; ++i) { int R, C; stage_rc(tid * 16 + i * 8192, R, C); const int Rb = Epi::PERM ? ((R & ~31) + perm32(R & 31)) : R;
        voffA[i] = (unsigned)(R * g.lda + C) * 2u; voffB[i] = (unsigned)(Rb * g.ldb + C) * 2u; }
    const size_t kstep = (size_t)(BK * 2);
    const size_t hstepA = (size_t)HALF * g.lda * 2, hstepB = (size_t)HALF * g.ldb * 2;
    const size_t tstepA = 2 * hstepA, tstepB = 2 * hstepB;
    const unsigned ldsw = (unsigned)wid * 1024u;
    const int aoff = lds_byte(wr * 64 + fr, fq * 8), boff = lds_byte(wc * 32 + fr, fq * 8);
#define PG8_SA(b, h) (((b) * 2 + (h)) * HTB)
#define PG8_SB(b, h) ((4 + (b) * 2 + (h)) * HTB)
#define PG8_STAGE(bufoff, gbase, voff) do { _Pragma("unroll") for (int _i = 0; _i < 2; ++_i) \
        __builtin_amdgcn_global_load_lds((const unsigned*)((const char*)(gbase) + (voff)[_i]), (LAS unsigned*)(lds + (bufoff) + ldsw + _i * 8192), 16, 0, 0); } while (0)
#define PG8_LDA(dst, b, h) do { _Pragma("unroll") for (int m = 0; m < 4; ++m) _Pragma("unroll") for (int k = 0; k < 2; ++k) dst[m][k] = *(const LAS bf16x8*)(lds + PG8_SA(b, h) + aoff + m * 2048 + k * 1024); } while (0)
#define PG8_LDB(dst, b, h) do { _Pragma("unroll") for (int n = 0; n < 2; ++n) _Pragma("unroll") for (int k = 0; k < 2; ++k) dst[n][k] = *(const LAS bf16x8*)(lds + PG8_SB(b, h) + boff + n * 2048 + k * 1024); } while (0)
#define PG8_MMA(ai, bj, At, Bt) do { __builtin_amdgcn_s_setprio(1); _Pragma("unroll") for (int m = 0; m < 4; ++m) _Pragma("unroll") for (int n = 0; n < 2; ++n) _Pragma("unroll") for (int k = 0; k < 2; ++k) \
        acc[ai][bj][m][n] = __builtin_amdgcn_mfma_f32_16x16x32_bf16(Bt[n][k], At[m][k], acc[ai][bj][m][n], 0, 0, 0); __builtin_amdgcn_s_setprio(0); } while (0)
#define PG8_WAIT_V(n) asm volatile("s_waitcnt vmcnt(" #n ")" ::: "memory")
#define PG8_WAIT_L(n) asm volatile("s_waitcnt lgkmcnt(" #n ")" ::: "memory")
#define PG8_BAR __builtin_amdgcn_s_barrier()
#define PG8_SCHED __builtin_amdgcn_sched_barrier(0)
    Unit cur, nxt; int ui = 0;
    if (!S.next(0, cur)) return;
    f32x4 acc[2][2][4][2];
#pragma unroll
    for (int a = 0; a < 2; ++a)
#pragma unroll
        for (int b = 0; b < 2; ++b)
#pragma unroll
            for (int m = 0; m < 4; ++m)
#pragma unroll
                for (int n = 0; n < 2; ++n) acc[a][b][m][n] = (f32x4){0.f, 0.f, 0.f, 0.f};
    bf16x8 At[4][2], B0[2][2], B1[2][2];
    const char* cA = (const char*)g.A + (size_t)cur.z * g.zsA * 2 + (size_t)cur.pm * tstepA;
    const char* cB = (const char*)g.Bt + (size_t)cur.z * g.zsB * 2 + (size_t)cur.pn * tstepB;
    PG8_STAGE(PG8_SB(0, 0), cB, voffB); PG8_STAGE(PG8_SA(0, 0), cA, voffA); PG8_STAGE(PG8_SB(0, 1), cB + hstepB, voffB); PG8_STAGE(PG8_SA(0, 1), cA + hstepA, voffA);
    if (wr == 1) PG8_BAR;
    PG8_WAIT_V(4); PG8_BAR;
    PG8_STAGE(PG8_SB(1, 0), cB + kstep, voffB); PG8_STAGE(PG8_SA(1, 0), cA + kstep, voffA); PG8_STAGE(PG8_SB(1, 1), cB + hstepB + kstep, voffB);
    PG8_WAIT_V(6); PG8_BAR;
    for (;;) {
        const bool has_next = S.next(ui + 1, nxt);
        const char* nA = has_next ? (const char*)g.A + (size_t)nxt.z * g.zsA * 2 + (size_t)nxt.pm * tstepA : cA;
        const char* nB = has_next ? (const char*)g.Bt + (size_t)nxt.z * g.zsB * 2 + (size_t)nxt.pn * tstepB : cB;
        for (int t = 0; t < nt; t += 2) {
            const bool last = (t == nt - 2);
            const char* a1 = cA + (size_t)(t + 1) * kstep;
            const char* a2 = last ? nA : cA + (size_t)(t + 2) * kstep; const char* b2 = last ? nB : cB + (size_t)(t + 2) * kstep;
            const char* a3 = a2 + kstep; const char* b3 = b2 + kstep;
            PG8_LDB(B0, 0, 0); PG8_SCHED; PG8_LDA(At, 0, 0); PG8_STAGE(PG8_SA(1, 1), a1 + hstepA, voffA);
            PG8_WAIT_L(8); PG8_BAR; PG8_WAIT_L(0); PG8_MMA(0, 0, At, B0); PG8_BAR; PG8_SCHED;
            PG8_LDB(B1, 0, 1); PG8_STAGE(PG8_SB(0, 0), b2, voffB);
            PG8_BAR; PG8_WAIT_L(0); PG8_MMA(0, 1, At, B1); PG8_BAR;
            PG8_LDA(At, 0, 1); PG8_STAGE(PG8_SA(0, 0), a2, voffA);
            PG8_BAR; PG8_WAIT_L(0); PG8_MMA(1, 0, At, B0); PG8_BAR; PG8_SCHED;
            PG8_STAGE(PG8_SB(0, 1), b2 + hstepB, voffB);
            PG8_WAIT_V(6); PG8_BAR; PG8_MMA(1, 1, At, B1); PG8_BAR;
            PG8_LDB(B0, 1, 0); PG8_SCHED; PG8_LDA(At, 1, 0); PG8_STAGE(PG8_SA(0, 1), a2 + hstepA, voffA);
            PG8_WAIT_L(8); PG8_BAR; PG8_WAIT_L(0); PG8_MMA(0, 0, At, B0); PG8_BAR; PG8_SCHED;
            PG8_LDB(B1, 1, 1); PG8_STAGE(PG8_SB(1, 0), b3, voffB);
            PG8_BAR; PG8_WAIT_L(0); PG8_MMA(0, 1, At, B1); PG8_BAR;
            PG8_LDA(At, 1, 1); PG8_STAGE(PG8_SA(1, 0), a3, voffA);
            PG8_BAR; PG8_WAIT_L(0); PG8_MMA(1, 0, At, B0); PG8_BAR; PG8_SCHED;
            PG8_STAGE(PG8_SB(1, 1), b3 + hstepB, voffB);
            PG8_WAIT_V(6); PG8_BAR; PG8_MMA(1, 1, At, B1); PG8_BAR;
        }
        E(acc, cur, wr, wc, fr, fq);
        if (!has_next) break;
#pragma unroll
        for (int a = 0; a < 2; ++a)
#pragma unroll
            for (int b = 0; b < 2; ++b)
#pragma unroll
                for (int m = 0; m < 4; ++m)
#pragma unroll
                    for (int n = 0; n < 2; ++n) acc[a][b][m][n] = (f32x4){0.f, 0.f, 0.f, 0.f};
        cur = nxt; cA = nA; cB = nB; ++ui;
    }
    PG8_WAIT_V(0);
    if (wr == 0) PG8_BAR;
    PG8_BAR;
#undef PG8_SA
#undef PG8_SB
#undef PG8_STAGE
#undef PG8_LDA
#undef PG8_LDB
#undef PG8_MMA
#undef PG8_WAIT_V
#undef PG8_WAIT_L
#undef PG8_BAR
#undef PG8_SCHED
}
}
using pg8::Unit;

enum { EP_PLAIN = 0, EP_ROPE = 1, EP_S5IN = 2, EP_F32 = 3, EP_S5OUT = 4, EP_GLU = 5, EP_RES = 6 };
template <int MODE> struct Epi {
    static constexpr bool PERM = (MODE != EP_F32 && MODE != EP_RES);
    bf16_t* O; int ldc;
    const float* rope;
    bf16_t* UH;
    float* C32; long zsC;
    const bf16_t* PZ; const float* bias;
    const float* xin_lat; const float* xin_ctx; float* xout_lat; float* xout_ctx; const float* gate; int chunk; float alpha;
    DI void operator()(const f32x4 (&acc)[2][2][4][2], const Unit& u, int wr, int wc, int fr, int fq) const {
        if constexpr (MODE == EP_PLAIN || MODE == EP_ROPE || MODE == EP_S5IN) {
            const int colt = u.pn * 256;
            const int t9 = u.pm % 9;
            const bool dorope = (MODE == EP_ROPE) && (colt < 2560) && (t9 != 0);
            const bool scat = (MODE == EP_S5IN) && (colt < 2048);
#pragma unroll
            for (int ai = 0; ai < 2; ++ai)
#pragma unroll
                for (int m = 0; m < 4; ++m) {
                    const int rl = u.pm * 256 + ai * 128 + wr * 64 + m * 16 + fr;
                    const int t = (t9 - 1) * 256 + ai * 128 + wr * 64 + m * 16 + fr;
#pragma unroll
                    for (int bj = 0; bj < 2; ++bj) {
                        f32x4 v0 = acc[ai][bj][m][0], v1 = acc[ai][bj][m][1];
                        const int c0 = colt + bj * 128 + wc * 32 + 8 * fq;
                        if (MODE == EP_ROPE && colt < 2048) { v0 = v0 * 0.12751743082459868f; v1 = v1 * 0.12751743082459868f; }
                        if (dorope) {
                            const int pos = (wc >> 1) ? (t & 63) : (t >> 6);
                            const int i0 = 16 * (wc & 1) + 4 * fq;
                            const f32x4 cs0 = *(const f32x4*)(rope + (pos * 32 + i0) * 2), cs1 = *(const f32x4*)(rope + (pos * 32 + i0) * 2 + 4);
                            f32x4 w0, w1;
                            w0[0] = v0[0] * cs0[0] - v0[1] * cs0[1]; w0[1] = v0[1] * cs0[0] + v0[0] * cs0[1];
                            w0[2] = v0[2] * cs0[2] - v0[3] * cs0[3]; w0[3] = v0[3] * cs0[2] + v0[2] * cs0[3];
                            w1[0] = v1[0] * cs1[0] - v1[1] * cs1[1]; w1[1] = v1[1] * cs1[0] + v1[0] * cs1[1];
                            w1[2] = v1[2] * cs1[2] - v1[3] * cs1[3]; w1[3] = v1[3] * cs1[2] + v1[2] * cs1[3];
                            v0 = w0; v1 = w1;
                        }
                        u32x4 w; w.x = pk2(v0[0], v0[1]); w.y = pk2(v0[2], v0[3]); w.z = pk2(v1[0], v1[1]); w.w = pk2(v1[2], v1[3]);
                        if (scat) {
                            const int gI = c0 >> 4, n0 = c0 & 15, bl = rl / TPB, loc = rl - bl * TPB, cc = loc >> 4, tau = loc & 15;
                            *(u32x4*)(UH + ((size_t)gI * 1280 + bl * 144 + cc) * 512 + tau * 16 + n0) = w;
                        } else {
                            *(u32x4*)(O + (size_t)u.z * zsC + (size_t)rl * ldc + c0) = w;
                        }
                    }
                }
        } else if constexpr (MODE == EP_F32) {
            float* base = C32 + (size_t)u.z * zsC;
#pragma unroll
            for (int ai = 0; ai < 2; ++ai)
#pragma unroll
                for (int m = 0; m < 4; ++m) {
                    const int rl = u.pm * 256 + ai * 128 + wr * 64 + m * 16 + fr;
#pragma unroll
                    for (int bj = 0; bj < 2; ++bj)
#pragma unroll
                        for (int n = 0; n < 2; ++n) *(f32x4*)(base + (size_t)rl * ldc + u.pn * 256 + bj * 128 + wc * 32 + n * 16 + 4 * fq) = acc[ai][bj][m][n];
                }
        } else if constexpr (MODE == EP_S5OUT) {
#pragma unroll
            for (int ai = 0; ai < 2; ++ai)
#pragma unroll
                for (int m = 0; m < 4; ++m) {
                    const int rl = u.pm * 256 + ai * 128 + wr * 64 + m * 16 + fr;
                    if (rl < NB * 144) {
                        const int bl = rl / 144, cc = rl - bl * 144;
#pragma unroll
                        for (int bj = 0; bj < 2; ++bj) {
                            const f32x4 v0 = acc[ai][bj][m][0], v1 = acc[ai][bj][m][1];
                            const int c0 = bj * 128 + wc * 32 + 8 * fq, tau = c0 >> 4, n0 = c0 & 15;
                            u32x4 w; w.x = pk2(gelu_tanh(v0[0]), gelu_tanh(v0[1])); w.y = pk2(gelu_tanh(v0[2]), gelu_tanh(v0[3]));
                            w.z = pk2(gelu_tanh(v1[0]), gelu_tanh(v1[1])); w.w = pk2(gelu_tanh(v1[2]), gelu_tanh(v1[3]));
                            *(u32x4*)(O + ((size_t)bl * TPB + cc * 16 + tau) * 4096 + u.z * 16 + n0) = w;
                        }
                    }
                }
        } else if constexpr (MODE == EP_GLU) {
#pragma unroll
            for (int ai = 0; ai < 2; ++ai)
#pragma unroll
                for (int m = 0; m < 4; ++m) {
                    const int rl = u.pm * 256 + ai * 128 + wr * 64 + m * 16 + fr;
#pragma unroll
                    for (int bj = 0; bj < 2; ++bj) {
                        const f32x4 v0 = acc[ai][bj][m][0], v1 = acc[ai][bj][m][1];
                        const int c0 = u.pn * 256 + bj * 128 + wc * 32 + 8 * fq;
                        const u32x4 g8 = *(const u32x4*)(PZ + (size_t)rl * 4096 + c0), z8 = *(const u32x4*)(PZ + (size_t)rl * 4096 + 2048 + c0);
                        const f32x4 b0 = *(const f32x4*)(bias + c0), b1 = *(const f32x4*)(bias + c0 + 4);
                        float o[8];
                        o[0] = glu_gate(bflo(g8.x), v0[0] + b0[0], bflo(z8.x)); o[1] = glu_gate(bfhi(g8.x), v0[1] + b0[1], bfhi(z8.x));
                        o[2] = glu_gate(bflo(g8.y), v0[2] + b0[2], bflo(z8.y)); o[3] = glu_gate(bfhi(g8.y), v0[3] + b0[3], bfhi(z8.y));
                        o[4] = glu_gate(bflo(g8.z), v1[0] + b1[0], bflo(z8.z)); o[5] = glu_gate(bfhi(g8.z), v1[1] + b1[1], bfhi(z8.z));
                        o[6] = glu_gate(bflo(g8.w), v1[2] + b1[2], bflo(z8.w)); o[7] = glu_gate(bfhi(g8.w), v1[3] + b1[3], bfhi(z8.w));
                        u32x4 w; w.x = pk2(o[0], o[1]); w.y = pk2(o[2], o[3]); w.z = pk2(o[4], o[5]); w.w = pk2(o[6], o[7]);
                        *(u32x4*)(O + (size_t)rl * ldc + c0) = w;
                    }
                }
        } else {
            const int bg = chunk + u.pm / 9, t9 = u.pm % 9;
            const float* xi; float* xo; const float* gt;
            if (t9 == 0) { xi = xin_ctx + (size_t)bg * 256 * D; xo = xout_ctx + (size_t)bg * 256 * D; gt = gate + 32 * 3072; }
            else { xi = xin_lat + ((size_t)bg * 2048 + (t9 - 1) * 256) * D; xo = xout_lat + ((size_t)bg * 2048 + (t9 - 1) * 256) * D; gt = gate + bg * 3072; }
#pragma unroll
            for (int ai = 0; ai < 2; ++ai)
#pragma unroll
                for (int m = 0; m < 4; ++m) {
                    const int rr = ai * 128 + wr * 64 + m * 16 + fr;
#pragma unroll
                    for (int bj = 0; bj < 2; ++bj)
#pragma unroll
                        for (int n = 0; n < 2; ++n) {
                            const int c = u.pn * 256 + bj * 128 + wc * 32 + n * 16 + 4 * fq;
                            const f32x4 xv = *(const f32x4*)(xi + (size_t)rr * D + c), gv = *(const f32x4*)(gt + c);
                            *(f32x4*)(xo + (size_t)rr * D + c) = xv * alpha + gv * acc[ai][bj][m][n];
                        }
                }
        }
    }
};

DI int qk_perm_row(int n) { const int head = n >> 7, d = n & 127, grp = d >> 6, j = d & 63, i = j & 31, part = j >> 5; return head * 128 + grp * 64 + 2 * i + part; }
DI void transpose_item(const float* W, int K, int N, bf16_t* WT, int permlim, LAS float* scr, int item, int lane) {
    const int nblk = N / 32, kb = item / nblk, nb = item % nblk, k0 = 64 * kb, n0 = 32 * nb;
#pragma unroll 8
    for (int i = 0; i < 32; ++i) { const int kk = 2 * i + (lane >> 5); scr[kk * 33 + (lane & 31)] = W[(size_t)(k0 + kk) * N + n0 + (lane & 31)]; }
    asm volatile("s_waitcnt lgkmcnt(0)" ::: "memory");
    const int c = lane & 7;
#pragma unroll
    for (int j = 0; j < 4; ++j) { const int n = (lane >> 3) + 8 * j; const LAS float* s = scr + (8 * c) * 33 + n;
        u32x4 o; o.x = pk2(s[0 * 33], s[1 * 33]); o.y = pk2(s[2 * 33], s[3 * 33]); o.z = pk2(s[4 * 33], s[5 * 33]); o.w = pk2(s[6 * 33], s[7 * 33]);
        const int ng = n0 + n, row = (ng < permlim) ? qk_perm_row(ng) : ng;
        *(u32x4*)(WT + (size_t)row * K + k0 + 8 * c) = o; }
    asm volatile("s_waitcnt lgkmcnt(0)" ::: "memory");
}

DI void phase_prologue(PRef P, LAS unsigned char* lds) {
    const int tid = opaque_tid(), lane = tid & 63, wave = tid >> 6, G = gridDim.x;
    {
        LAS float* scr = (LAS float*)(lds + wave * 8448);
        const int gw = blockIdx.x * 8 + wave, NGW = G * 8;
        constexpr int I_ATT = 16 * 160, I_S5 = 16 * 128, I_HG = 16 * 320, I_OUT = 32 * 32, I_GLU = 32 * 64;
        constexpr int NIT = 2 * I_ATT + I_S5 + I_HG + 4 * I_OUT + I_GLU;
        for (int it = gw; it < NIT; it += NGW) {
            int r = it;
            if (r < 2 * I_ATT) { const int j = r / I_ATT; transpose_item(P.in[IN_ATTW] + (size_t)j * 1024 * 5120, 1024, 5120, (bf16_t*)(P.ws + OFF_WT_ATT) + (size_t)j * 5120 * 1024, 2560, scr, r % I_ATT, lane); continue; }
            r -= 2 * I_ATT;
            if (r < I_S5) { transpose_item(P.in[IN_S5W], 1024, 4096, (bf16_t*)(P.ws + OFF_WT_S5), 0, scr, r, lane); continue; }
            r -= I_S5;
            if (r < I_HG) { transpose_item(P.in[IN_HGW], 1024, 10240, (bf16_t*)(P.ws + OFF_WT_HG), 0, scr, r, lane); continue; }
            r -= I_HG;
            if (r < 4 * I_OUT) { const int j = r / I_OUT; transpose_item(P.in[IN_WOUT] + (size_t)j * 2048 * 1024, 2048, 1024, (bf16_t*)(P.ws + OFF_WT_OUT) + (size_t)j * 1024 * 2048, 0, scr, r % I_OUT, lane); continue; }
            r -= 4 * I_OUT;
            transpose_item(P.in[IN_GLUW], 2048, 2048, (bf16_t*)(P.ws + OFF_WT_GLU), 0, scr, r, lane);
        }
    }
    {
        float* rope = (float*)(P.ws + OFF_ROPE);
        for (int idx = blockIdx.x * 512 + tid; idx < 2048; idx += G * 512) {
            const int pos = idx >> 5, i = idx & 31;
            const float invf = exp2f(-(float)i * (13.287712379549449f / 32.0f));
            const float ang = (float)pos * invf;
            rope[idx * 2] = cosf(ang); rope[idx * 2 + 1] = sinf(ang);
        }
    }
    __syncthreads();
    {
        LAS float* SC = (LAS float*)lds;
        float* mods = (float*)(P.ws + OFF_MODS);
        bool filled = false;
        for (int it = blockIdx.x; it < 192; it += G) {
            if (!filled) {
                for (int i = tid; i < 33 * 1024; i += 512) { const int bi = i >> 10, k = i & 1023; const float cv = (bi < 32) ? P.in[IN_C][bi * 1024 + k] : P.in[IN_CCTX][k]; SC[i] = siluf_(cv); }
                filled = true;
            }
            __syncthreads();
            const int layer = it / 48, col = (it % 48) * 64 + lane;
            const float* W = P.in[IN_ADAW] + (size_t)layer * 1024 * 3072 + col;
            float a[33];
#pragma unroll
            for (int b = 0; b < 33; ++b) a[b] = 0.f;
            for (int k = wave * 128; k < wave * 128 + 128; ++k) {
                const float w = W[(size_t)k * 3072];
#pragma unroll
                for (int b = 0; b < 33; ++b) a[b] += SC[b * 1024 + k] * w;
            }
            __syncthreads();
            LAS float* RED = (LAS float*)lds;
#pragma unroll
            for (int b = 0; b < 33; ++b) RED[(wave * 33 + b) * 64 + lane] = a[b];
            __syncthreads();
            for (int o = tid; o < 33 * 64; o += 512) {
                const int b = o >> 6, l = o & 63; float s = 0.f;
#pragma unroll
                for (int w = 0; w < 8; ++w) s += RED[(w * 33 + b) * 64 + l];
                const int cc = (it % 48) * 64 + l;
                mods[((size_t)layer * 33 + b) * 3072 + cc] = s + P.in[IN_ADAB][layer * 3072 + cc];
            }
            __syncthreads();
            filled = false;
        }
    }
    __syncthreads();
    {
        LAS f32x2* APOW = (LAS f32x2*)lds;
        LAS f32x2* BBAR = (LAS f32x2*)(lds + 17408);
        LAS f32x2* CM = (LAS f32x2*)(lds + 17408 + 16384);
        LAS float* KT = (LAS float*)(lds + 17408 + 32768);
        bf16_t* BT1 = (bf16_t*)(P.ws + OFF_BT1); bf16_t* BT3 = (bf16_t*)(P.ws + OFF_BT3);
        for (int g = G - 1 - blockIdx.x; g < 128; g += G) {
            if (g < 0) break;
            for (int i = tid; i < 2 * 17 * 64; i += 512) {
                const int p = i & 63, k = (i >> 6) % 17, dir = i / (17 * 64);
                const float lre = P.in[IN_LRE][(dir * 128 + g) * 64 + p], lim = P.in[IN_LIM][(dir * 128 + g) * 64 + p], dt = expf(P.in[IN_LSTEP][dir * 128 + g]);
                const float mag = expf((float)k * lre * dt), ang = (float)k * lim * dt;
                APOW[i] = (f32x2){mag * cosf(ang), mag * sinf(ang)};
            }
            for (int i = tid; i < 2048; i += 512) {
                const int n = i & 15, p = (i >> 4) & 63, dir = i >> 10;
                const float lre = P.in[IN_LRE][(dir * 128 + g) * 64 + p], lim = P.in[IN_LIM][(dir * 128 + g) * 64 + p], dt = expf(P.in[IN_LSTEP][dir * 128 + g]);
                const float mag = expf(lre * dt), ang = lim * dt;
                const float nr = mag * cosf(ang) - 1.0f, ni = mag * sinf(ang), den = 1.0f / (lre * lre + lim * lim);
                const float cr = (nr * lre + ni * lim) * den, ci = (ni * lre - nr * lim) * den;
                const size_t bi = (((size_t)dir * 128 + g) * 64 + p) * 16 + n;
                const float br = P.in[IN_BRE][bi], bim = P.in[IN_BIM][bi];
                BBAR[i] = (f32x2){cr * br - ci * bim, cr * bim + ci * br};
                const int p2 = i & 63, n2 = (i >> 6) & 15;
                const size_t cidx = (((size_t)dir * 128 + g) * 16 + n2) * 64 + p2;
                CM[i] = (f32x2){P.in[IN_CRE][cidx], P.in[IN_CIM][cidx]};
            }
            __syncthreads();
            for (int i = tid; i < 8192; i += 512) {
                const int ni = i & 15, no = (i >> 4) & 15, k = (i >> 8) & 15, dir = i >> 12;
                float s = 0.f;
                for (int p = 0; p < 64; ++p) {
                    const f32x2 a = APOW[(dir * 17 + k) * 64 + p], b = BBAR[(dir * 64 + p) * 16 + ni], c = CM[(dir * 16 + no) * 64 + p];
                    const float wr_ = a.x * b.x - a.y * b.y, wi_ = a.x * b.y + a.y * b.x;
                    s += c.x * wr_ - c.y * wi_;
                }
                KT[i] = s;
            }
            __syncthreads();
            for (int v = tid; v < 256 * 32; v += 512) {
                const int nidx = v >> 5, kk0 = (v & 31) * 8, dir = nidx >> 7, p = (nidx >> 1) & 63, ri = nidx & 1, tau = kk0 >> 4, n0 = kk0 & 15;
                const int e = dir ? tau : 15 - tau;
                const f32x2 a = APOW[(dir * 17 + e) * 64 + p];
                float o[8];
#pragma unroll
                for (int j = 0; j < 8; ++j) { const f32x2 b = BBAR[(dir * 64 + p) * 16 + n0 + j]; o[j] = ri ? (a.x * b.y + a.y * b.x) : (a.x * b.x - a.y * b.y); }
                u32x4 w; w.x = pk2(o[0], o[1]); w.y = pk2(o[2], o[3]); w.z = pk2(o[4], o[5]); w.w = pk2(o[6], o[7]);
                *(u32x4*)(BT1 + ((size_t)g * 256 + nidx) * 256 + kk0) = w;
            }
            for (int v = tid; v < 256 * 64; v += 512) {
                const int nidx = v >> 6, kk0 = (v & 63) * 8, tau = nidx >> 4, no = nidx & 15;
                float o[8];
                if (kk0 < 256) {
                    const int s = kk0 >> 4, ni0 = kk0 & 15;
#pragma unroll
                    for (int j = 0; j < 8; ++j) {
                        float x = 0.f;
                        if (tau >= s) x += KT[((0 * 16 + (tau - s)) * 16 + no) * 16 + ni0 + j];
                        if (s >= tau) x += KT[((1 * 16 + (s - tau)) * 16 + no) * 16 + ni0 + j];
                        if (s == tau && ni0 + j == no) x += P.in[IN_S5D][g * 16 + no];
                        o[j] = x;
                    }
                } else {
                    const int q = kk0 - 256, dir = q >> 7, p0 = (q & 127) >> 1;
                    const int e = dir ? 16 - tau : tau + 1;
#pragma unroll
                    for (int j = 0; j < 4; ++j) {
                        const f32x2 a = APOW[(dir * 17 + e) * 64 + p0 + j], c = CM[(dir * 16 + no) * 64 + p0 + j];
                        o[2 * j] = c.x * a.x - c.y * a.y; o[2 * j + 1] = -(c.x * a.y + c.y * a.x);
                    }
                }
                u32x4 w; w.x = pk2(o[0], o[1]); w.y = pk2(o[2], o[3]); w.z = pk2(o[4], o[5]); w.w = pk2(o[6], o[7]);
                *(u32x4*)(BT3 + ((size_t)g * 256 + nidx) * 512 + kk0) = w;
            }
            __syncthreads();
        }
    }
}

DI size_t xrow_off(int b0, int rl, bool& isctx, int& bg) { const int bl = rl / TPB, loc = rl - bl * TPB; bg = b0 + bl; isctx = loc < 256; return isctx ? ((size_t)bg * 256 + loc) * D : ((size_t)bg * 2048 + (loc - 256)) * D; }

DI void phase_modulate0(PRef P) {
    const float* mods = (const float*)(P.ws + OFF_MODS);
    bf16_t* H = (bf16_t*)(P.ws + OFF_H);
    const size_t GT = (size_t)gridDim.x * 512, NIT = (size_t)73728 * 128;
    for (size_t i0 = (size_t)blockIdx.x * 512 + opaque_tid(); i0 < NIT; i0 += 4 * GT) {
        f32x4 x0[4], x1[4]; const float* mp[4];
#pragma unroll
        for (int k = 0; k < 4; ++k) {
            const size_t i = i0 + k * GT;
            if (i < NIT) {
                const int row = (int)(i >> 7), c = (int)(i & 127) * 8;
                bool isctx; int bg; const size_t off = xrow_off(0, row, isctx, bg);
                const float* xp = (isctx ? P.in[IN_CTX] : P.in[IN_X]) + off + c;
                mp[k] = mods + (size_t)(isctx ? 32 : bg) * 3072 + c;
                x0[k] = *(const f32x4*)xp; x1[k] = *(const f32x4*)(xp + 4);
            } else { mp[k] = mods; x0[k] = (f32x4){0.f, 0.f, 0.f, 0.f}; x1[k] = x0[k]; }
        }
#pragma unroll
        for (int k = 0; k < 4; ++k) {
            const size_t i = i0 + k * GT;
            if (i < NIT) {
                const int row = (int)(i >> 7), c = (int)(i & 127) * 8;
                const f32x4 sh0 = *(const f32x4*)mp[k], sh1 = *(const f32x4*)(mp[k] + 4), sc0 = *(const f32x4*)(mp[k] + 1024), sc1 = *(const f32x4*)(mp[k] + 1028);
                const f32x4 h0 = x0[k] * (sc0 + 1.0f) + sh0, h1 = x1[k] * (sc1 + 1.0f) + sh1;
                u32x4 w; w.x = pk2(h0[0], h0[1]); w.y = pk2(h0[2], h0[3]); w.z = pk2(h1[0], h1[1]); w.w = pk2(h1[2], h1[3]);
                *(u32x4*)(H + (size_t)row * D + c) = w;
            }
        }
    }
}

DI void phase_ln(PRef P, int layer, int b0, int nb, int wg0 = 0, int nwg = 0) {
    const int NROWS = nb * TPB;
    const bool last = layer == 3;
    const float* mods = (const float*)(P.ws + OFF_MODS) + (size_t)(layer + 1) * 33 * 3072;
    const float* lg = P.in[IN_LNG] + layer * D; const float* lb = P.in[IN_LNB] + layer * D;
    bf16_t* H = (bf16_t*)(P.ws + OFF_H);
    float* xctx = (float*)(P.ws + OFF_XCTX);
    if (nwg == 0) nwg = gridDim.x;
    if ((int)blockIdx.x < wg0 || (int)blockIdx.x >= wg0 + nwg) return;
    const int tid_ = opaque_tid(), lane = tid_ & 63, gw = ((int)blockIdx.x - wg0) * 8 + (tid_ >> 6), NGW = nwg * 8;
    for (int rl0 = gw; rl0 < NROWS; rl0 += 3 * NGW) {
        f32x4 v[3][4]; float* xp[3]; const float* mp[3]; bool ok[3]; int rls[3];
#pragma unroll
        for (int k = 0; k < 3; ++k) {
            const int rl = rl0 + k * NGW; rls[k] = rl;
            bool isctx = false; int bg = 0; size_t off = 0;
            ok[k] = rl < NROWS;
            if (ok[k]) off = xrow_off(b0, rl, isctx, bg);
            if (last && isctx) ok[k] = false;
            xp[k] = (isctx ? xctx : P.out) + off;
            mp[k] = mods + (size_t)(isctx ? 32 : bg) * 3072;
            if (ok[k]) {
#pragma unroll
                for (int j = 0; j < 4; ++j) v[k][j] = *(const f32x4*)(xp[k] + (lane + 64 * j) * 4);
            } else {
#pragma unroll
                for (int j = 0; j < 4; ++j) v[k][j] = (f32x4){0.f, 0.f, 0.f, 0.f};
            }
        }
        float s[3], s2[3];
#pragma unroll
        for (int k = 0; k < 3; ++k) { s[k] = 0.f;
#pragma unroll
            for (int j = 0; j < 4; ++j) s[k] += (v[k][j][0] + v[k][j][1]) + (v[k][j][2] + v[k][j][3]); }
#pragma unroll
        for (int o = 1; o < 64; o <<= 1)
#pragma unroll
            for (int k = 0; k < 3; ++k) s[k] += __shfl_xor(s[k], o);
#pragma unroll
        for (int k = 0; k < 3; ++k) { const float mean = s[k] * (1.0f / D); s2[k] = 0.f;
#pragma unroll
            for (int j = 0; j < 4; ++j) { v[k][j] = v[k][j] - mean; s2[k] += (v[k][j][0] * v[k][j][0] + v[k][j][1] * v[k][j][1]) + (v[k][j][2] * v[k][j][2] + v[k][j][3] * v[k][j][3]); } }
#pragma unroll
        for (int o = 1; o < 64; o <<= 1)
#pragma unroll
            for (int k = 0; k < 3; ++k) s2[k] += __shfl_xor(s2[k], o);
#pragma unroll
        for (int k = 0; k < 3; ++k) {
            if (!ok[k]) continue;
            const float rstd = rsqrtf(s2[k] * (1.0f / D) + 1e-5f);
#pragma unroll
            for (int j = 0; j < 4; ++j) {
                const int c = (lane + 64 * j) * 4;
                const f32x4 y = v[k][j] * rstd * *(const f32x4*)(lg + c) + *(const f32x4*)(lb + c);
                *(f32x4*)(xp[k] + c) = y;
                if (!last) {
                    const f32x4 h = y * (*(const f32x4*)(mp[k] + 1024 + c) + 1.0f) + *(const f32x4*)(mp[k] + c);
                    u32x2 w; w.x = pk2(h[0], h[1]); w.y = pk2(h[2], h[3]);
                    *(u32x2*)(H + ((size_t)b0 * TPB + rls[k]) * D + c) = w;
                }
            }
        }
    }
}

DI bool ln_row_load(PRef P, int b0, int nrows, int rl, int lane, f32x4 (&v)[4]) {
    if (rl >= nrows) return false;
    bool isctx; int bg; const size_t off = xrow_off(b0, rl, isctx, bg);
    const float* xp = (isctx ? (const float*)(P.ws + OFF_XCTX) : (const float*)P.out) + off;
#pragma unroll
    for (int j = 0; j < 4; ++j) v[j] = *(const f32x4*)(xp + (lane + 64 * j) * 4);
    return true;
}
DI void ln_row_finish(PRef P, int layer, int b0, int rl, int lane, f32x4 (&v)[4]) {
    bool isctx; int bg; const size_t off = xrow_off(b0, rl, isctx, bg);
    float* xp = (isctx ? (float*)(P.ws + OFF_XCTX) : P.out) + off;
    const float* mp = (const float*)(P.ws + OFF_MODS) + (size_t)(layer + 1) * 33 * 3072 + (size_t)(isctx ? 32 : bg) * 3072;
    const float* lg = P.in[IN_LNG] + layer * D; const float* lb = P.in[IN_LNB] + layer * D;
    bf16_t* H = (bf16_t*)(P.ws + OFF_H);
    float s = 0.f;
#pragma unroll
    for (int j = 0; j < 4; ++j) s += (v[j][0] + v[j][1]) + (v[j][2] + v[j][3]);
#pragma unroll
    for (int o = 1; o < 64; o <<= 1) s += __shfl_xor(s, o);
    const float mean = s * (1.0f / D); float s2 = 0.f;
#pragma unroll
    for (int j = 0; j < 4; ++j) { v[j] = v[j] - mean; s2 += (v[j][0] * v[j][0] + v[j][1] * v[j][1]) + (v[j][2] * v[j][2] + v[j][3] * v[j][3]); }
#pragma unroll
    for (int o = 1; o < 64; o <<= 1) s2 += __shfl_xor(s2, o);
    const float rstd = rsqrtf(s2 * (1.0f / D) + 1e-5f);
#pragma unroll
    for (int j = 0; j < 4; ++j) {
        const int c = (lane + 64 * j) * 4;
        const f32x4 y = v[j] * rstd * *(const f32x4*)(lg + c) + *(const f32x4*)(lb + c);
        *(f32x4*)(xp + c) = y;
        const f32x4 h = y * (*(const f32x4*)(mp + 1024 + c) + 1.0f) + *(const f32x4*)(mp + c);
        u32x2 w; w.x = pk2(h[0], h[1]); w.y = pk2(h[2], h[3]);
        *(u32x2*)(H + ((size_t)b0 * TPB + rl) * D + c) = w;
    }
}

DI void phase_attn(PRef P, LAS unsigned char* lds, int aj, bool last, int nb) {
    const bf16_t* PZ = (const bf16_t*)(P.ws + OFF_PZ);
    bf16_t* AO = (bf16_t*)(P.ws + OFF_AOUT);
    LAS bf16_t* Ks0 = (LAS bf16_t*)lds;
    LAS bf16_t* Vt0 = (LAS bf16_t*)(lds + 34816);
    const int tid = opaque_tid(), w = tid >> 6, lane = tid & 63, r = lane & 31, h = lane >> 5;
    const int nlat = nb * 128, nitems = last ? nlat : nlat + nb * 16;
    u32x4 kreg[2], vreg[2];
    bool have_pref = false;
    for (int it = blockIdx.x; it < nitems; it += gridDim.x) {
        int bl, hk, qb; bool isctx;
        if (it < nlat) { const int ip = (it & 7) * (nlat >> 3) + (it >> 3); bl = ip >> 7; hk = (ip >> 5) & 3; qb = ip & 31; isctx = false; }
        else { const int x = it - nlat; bl = x >> 4; hk = (x >> 2) & 3; qb = x & 3; isctx = true; }
        const int rowb = bl * TPB, s0 = qb * 64;
        const int head = hk * 4 + (w >> 1), qoff = 32 * (w & 1);
        const int qrow = rowb + (isctx ? 0 : 256) + s0 + qoff + r;
        bf16x8 qf[8];
        {
            LAS bf16_t* QL = (LAS bf16_t*)(lds + 75776) + w * (32 * 136);
            const int qrow0 = qrow - r;
            u32x4 t[8];
#pragma unroll
            for (int k = 0; k < 8; ++k) { const int p = lane + 64 * k, row = p >> 4, dg = p & 15; t[k] = *(const u32x4*)(PZ + (size_t)(qrow0 + row) * 5120 + head * 128 + dg * 8); }
#pragma unroll
            for (int k = 0; k < 8; ++k) { const int p = lane + 64 * k, row = p >> 4, dg = p & 15; *(LAS u32x4*)(QL + row * 136 + dg * 8) = t[k]; }
            asm volatile("s_waitcnt lgkmcnt(0)" ::: "memory");
#pragma unroll
            for (int s = 0; s < 8; ++s) qf[s] = *(const LAS bf16x8*)(QL + r * 136 + 16 * s + 8 * h);
        }
        int t_lo = 0, nw = 0;
        if (!isctx) { t_lo = s0 >= 128 ? 0 : (s0 >= 64 ? 1 : 2); int t_hi = (2176 - s0) / 64; if (t_hi > 5) t_hi = 5; nw = t_hi - t_lo; }
        const int ntiles = nw + 4;
        float m = P.in[IN_SINK][aj * 16 + head] * 1.4426950408889634f, l = h ? 0.0f : 1.0f;
        f32x16 oacc[4];
#pragma unroll
        for (int d = 0; d < 4; ++d)
#pragma unroll
            for (int i = 0; i < 16; ++i) oacc[d][i] = 0.f;
        auto tile_row0 = [&](int n) -> int { return n < nw ? rowb + 256 + s0 - 128 + 64 * (t_lo + n) : rowb + 64 * (n - nw); };
        auto prefetch_at = [&](int kr0, int hkx) {
#pragma unroll
            for (int i = 0; i < 2; ++i) { const int p = tid + 512 * i, key = p >> 4, dg = p & 15; kreg[i] = *(const u32x4*)(PZ + (size_t)(kr0 + key) * 5120 + 2048 + hkx * 128 + dg * 8); }
#pragma unroll
            for (int i = 0; i < 2; ++i) { const int p = tid + 512 * i, key = p >> 4, dg = p & 15; vreg[i] = *(const u32x4*)(PZ + (size_t)(kr0 + key) * 5120 + 2560 + hkx * 128 + dg * 8); }
        };
        auto prefetch = [&](int n) { prefetch_at(tile_row0(n), hk); };
        auto stage = [&](int bsel) {
            LAS bf16_t* Kd = Ks0 + bsel * 8704; LAS bf16_t* Vd = Vt0 + bsel * 10240;
#pragma unroll
            for (int i = 0; i < 2; ++i) { const int p = tid + 512 * i, key = p >> 4, dg = p & 15; *(LAS u32x4*)(Kd + key * 136 + dg * 8) = kreg[i]; *(LAS u32x4*)(Vd + key * 160 + dg * 8) = vreg[i]; }
        };
        if (!have_pref) prefetch(0);
        stage(0);
        if (ntiles > 1) prefetch(1);
        __syncthreads();
        for (int n = 0; n < ntiles; ++n) {
            const LAS bf16_t* Ks = Ks0 + (n & 1) * 8704; const LAS bf16_t* Vt = Vt0 + (n & 1) * 10240;
            f32x16 sacc[2];
            {
#pragma unroll
                for (int kt = 0; kt < 2; ++kt)
#pragma unroll
                    for (int i = 0; i < 16; ++i) sacc[kt][i] = -m;
#pragma unroll
                for (int sb = 0; sb < 2; ++sb) {
                    bf16x8 kf[2][4];
#pragma unroll
                    for (int kt = 0; kt < 2; ++kt)
#pragma unroll
                        for (int s = 0; s < 4; ++s) kf[kt][s] = *(const LAS bf16x8*)(Ks + (32 * kt + r) * 136 + 16 * (4 * sb + s) + 8 * h);
                    __builtin_amdgcn_sched_barrier(0);
#pragma unroll
                    for (int s = 0; s < 4; ++s) { sacc[0] = MFMA32(kf[0][s], qf[4 * sb + s], sacc[0]); sacc[1] = MFMA32(kf[1][s], qf[4 * sb + s], sacc[1]); }
                }
            }
            const int wt = t_lo + n;
            const bool edge = (n < nw) && (wt == 0 || wt == 4);
#pragma unroll
            for (int kt = 0; kt < 2; ++kt) {
                if (edge) {
                    const int kpos0 = s0 - 128 + 64 * wt + 32 * kt, qpos = s0 + qoff + r;
#pragma unroll
                    for (int i = 0; i < 16; ++i) { const int dlt = qpos - (kpos0 + crow(i, h)); if (dlt > 128 || dlt < -128) sacc[kt][i] = -1.0e30f; }
                }
                float mx = -3.0e38f;
#pragma unroll
                for (int i = 0; i < 16; ++i) mx = fmaxf(mx, sacc[kt][i]);
                mx = xhalf_max(mx);
                if (__builtin_amdgcn_ballot_w64(mx > 8.0f) != 0ull) {
                    const float dm = fmaxf(mx, 0.0f), alpha = __builtin_amdgcn_exp2f(-dm);
                    l *= alpha; m += dm;
#pragma unroll
                    for (int d = 0; d < 4; ++d)
#pragma unroll
                        for (int i = 0; i < 16; ++i) oacc[d][i] *= alpha;
#pragma unroll
                    for (int i = 0; i < 16; ++i) sacc[kt][i] -= dm;
                    if (kt == 0) {
#pragma unroll
                        for (int i = 0; i < 16; ++i) sacc[1][i] -= dm;
                    }
                }
#pragma unroll
                for (int i = 0; i < 16; ++i) { const float pv = __builtin_amdgcn_exp2f(sacc[kt][i]); sacc[kt][i] = pv; l += pv; }
#pragma unroll
                for (int s = 0; s < 2; ++s) {
                    u32x4 pw; pw.x = pk2(sacc[kt][8 * s], sacc[kt][8 * s + 1]); pw.y = pk2(sacc[kt][8 * s + 2], sacc[kt][8 * s + 3]);
                    pw.z = pk2(sacc[kt][8 * s + 4], sacc[kt][8 * s + 5]); pw.w = pk2(sacc[kt][8 * s + 6], sacc[kt][8 * s + 7]);
                    const bf16x8 pb = __builtin_bit_cast(bf16x8, pw);
#pragma unroll
                    for (int d = 0; d < 4; ++d) {
                        const LAS bf16_t* vb = Vt + (32 * kt + 16 * s + 4 * h + ((lane & 15) >> 2)) * 160 + 32 * d + 16 * ((lane >> 4) & 1) + 4 * (lane & 3);
                        const s16x4 lo = LDS_TR16(vb), hi = LDS_TR16(vb + 8 * 160);
                        const bf16x8 av = __builtin_shufflevector(lo, hi, 0, 1, 2, 3, 4, 5, 6, 7);
                        oacc[d] = MFMA32(av, pb, oacc[d]);
                    }
                }
            }
            if (n + 1 < ntiles) { stage((n + 1) & 1); if (n + 2 < ntiles) prefetch(n + 2); }
            else {
                const int itn = it + gridDim.x; have_pref = itn < nitems;
                if (have_pref) {
                    int bl2, hk2, qb2; bool ctx2;
                    if (itn < nlat) { const int ip = (itn & 7) * (nlat >> 3) + (itn >> 3); bl2 = ip >> 7; hk2 = (ip >> 5) & 3; qb2 = ip & 31; ctx2 = false; }
                    else { const int x = itn - nlat; bl2 = x >> 4; hk2 = (x >> 2) & 3; qb2 = x & 3; ctx2 = true; }
                    const int s2 = qb2 * 64, tl2 = ctx2 ? 0 : (s2 >= 128 ? 0 : (s2 >= 64 ? 1 : 2));
                    prefetch_at(ctx2 ? bl2 * TPB : bl2 * TPB + 256 + s2 - 128 + 64 * tl2, hk2);
                }
            }
            __syncthreads();
        }
        l = xhalf_sum(l);
        const float inv = 1.0f / l;
        {
            LAS bf16_t* OL = (LAS bf16_t*)lds + w * (32 * 136);
#pragma unroll
            for (int d = 0; d < 4; ++d)
#pragma unroll
                for (int gq = 0; gq < 4; ++gq) {
                    u32x2 o; o.x = pk2(oacc[d][4 * gq] * inv, oacc[d][4 * gq + 1] * inv); o.y = pk2(oacc[d][4 * gq + 2] * inv, oacc[d][4 * gq + 3] * inv);
                    *(LAS u32x2*)(OL + r * 136 + 32 * d + 8 * gq + 4 * h) = o;
                }
            asm volatile("s_waitcnt lgkmcnt(0)" ::: "memory");
            const int qrow0 = rowb + (isctx ? 0 : 256) + s0 + qoff;
#pragma unroll
            for (int hb = 0; hb < 2; ++hb) {
                u32x4 zz[4], ov[4];
#pragma unroll
                for (int k = 0; k < 4; ++k) { const int p = lane + 64 * (4 * hb + k), row = p >> 4, dg = p & 15;
                    zz[k] = *(const u32x4*)(PZ + (size_t)(qrow0 + row) * 5120 + 3072 + head * 128 + dg * 8);
                    ov[k] = *(const LAS u32x4*)(OL + row * 136 + dg * 8); }
#pragma unroll
                for (int k = 0; k < 4; ++k) { const int p = lane + 64 * (4 * hb + k), row = p >> 4, dg = p & 15;
                    u32x4 o;
                    o.x = pk2(bflo(ov[k].x) * siluf_(bflo(zz[k].x)), bfhi(ov[k].x) * siluf_(bfhi(zz[k].x)));
                    o.y = pk2(bflo(ov[k].y) * siluf_(bflo(zz[k].y)), bfhi(ov[k].y) * siluf_(bfhi(zz[k].y)));
                    o.z = pk2(bflo(ov[k].z) * siluf_(bflo(zz[k].z)), bfhi(ov[k].z) * siluf_(bfhi(zz[k].z)));
                    o.w = pk2(bflo(ov[k].w) * siluf_(bflo(zz[k].w)), bfhi(ov[k].w) * siluf_(bfhi(zz[k].w)));
                    *(u32x4*)(AO + (size_t)(qrow0 + row) * 2048 + head * 128 + dg * 8) = o; }
            }
        }
        __syncthreads();
    }
    __syncthreads();
}

DI void phase_s5scan(PRef P) {
    const bf16_t* HL = (const bf16_t*)(P.ws + OFF_HLOC);
    bf16_t* UH = (bf16_t*)(P.ws + OFF_UH);
    for (int idx = blockIdx.x * 512 + opaque_tid(); idx < 131072; idx += gridDim.x * 512) {
        const int p = idx & 63, dir = (idx >> 6) & 1, bl = (idx >> 7) & 7, g = idx >> 10;
        const float lre = P.in[IN_LRE][(dir * 128 + g) * 64 + p], lim = P.in[IN_LIM][(dir * 128 + g) * 64 + p], dt = expf(P.in[IN_LSTEP][dir * 128 + g]);
        const float mag = expf(16.0f * lre * dt), ang = 16.0f * lim * dt;
        const float ar = mag * cosf(ang), ai = mag * sinf(ang);
        float hr = 0.f, hi = 0.f;
        const size_t rb = (size_t)g * 1280 + bl * 144;
        for (int s0 = 0; s0 < 144; s0 += 16) {
            unsigned v[16]; int cs[16];
#pragma unroll
            for (int j = 0; j < 16; ++j) { const int st = s0 + j; cs[j] = dir ? (st < 16 ? 15 - st : 159 - st) : st; v[j] = *(const unsigned*)(HL + (rb + cs[j]) * 256 + dir * 128 + 2 * p); }
#pragma unroll
            for (int j = 0; j < 16; ++j) {
                *(unsigned*)(UH + (rb + cs[j]) * 512 + 256 + dir * 128 + 2 * p) = pk2(hr, hi);
                const float nr = ar * hr - ai * hi + bflo(v[j]), ni = ar * hi + ai * hr + bfhi(v[j]); hr = nr; hi = ni;
            }
        }
    }
}

DI void phase_hgrn(PRef P, LAS unsigned char* lds, int layer, int lnl, int lnb0, int lnnb) {
    bf16_t* PZ = (bf16_t*)(P.ws + OFF_PZ);
    LAS bf16_t* QS = (LAS bf16_t*)lds;
    LAS bf16_t* KS = (LAS bf16_t*)(lds + 17408);
    LAS bf16_t* VR = (LAS bf16_t*)(lds + 34816);
    LAS bf16_t* KDT = (LAS bf16_t*)(lds + 55296);
    LAS bf16_t* ST = (LAS bf16_t*)(lds + 73728);
    LAS float* TOT = (LAS float*)(lds + 109056);
    LAS float* EB = (LAS float*)(lds + 108544);
    const int tid = opaque_tid(), w = tid >> 6, lane = tid & 63, r = lane & 31, h = lane >> 5;
    const int seg = tid >> 6, c0 = (tid & 63) * 2;
    const int ln_gw = blockIdx.x * 8 + w, ln_ngw = gridDim.x * 8, ln_rows = lnnb * TPB; int ln_round = 0;
    for (int it = blockIdx.x; it < NB * 16 * 2; it += gridDim.x) {
        const int dir = it & 1, hd = (it >> 1) & 15, bl = it >> 5;
        const int rowb = bl * TPB;
        f32x2 lb2;
#pragma unroll
        for (int q = 0; q < 2; ++q) {
            const int e = hd * 128 + c0 + q; const float a0 = P.in[IN_HGLB][e], a1 = P.in[IN_HGLB][2048 + e], a2 = P.in[IN_HGLB][4096 + e], a3 = P.in[IN_HGLB][6144 + e];
            const float mxx = fmaxf(fmaxf(a0, a1), fmaxf(a2, a3)); const float e0 = __expf(a0 - mxx), e1 = __expf(a1 - mxx), e2 = __expf(a2 - mxx), e3 = __expf(a3 - mxx);
            const float ev[4] = {e0, e1, e2, e3}; float num = 0.f;
#pragma unroll
            for (int j = 1; j < 4; ++j) if (j <= layer) num += ev[j];
            lb2[q] = num / (e0 + e1 + e2 + e3);
        }
        const int fcol = 2048 + dir * 2048 + hd * 128;
        for (int i = tid; i < 128 * 136 / 2; i += 512) ((LAS unsigned*)ST)[i] = 0u;
        f32x16 sacc[2];
#pragma unroll
        for (int x = 0; x < 2; ++x)
#pragma unroll
            for (int i = 0; i < 16; ++i) sacc[x][i] = 0.f;
        auto grow = [&](int ci, int tau) -> int { const int q = ci * 64 + tau; return dir ? (ci < 4 ? rowb + 255 - q : rowb + 256 + 2047 - (q - 256)) : rowb + q; };
        u32x4 qreg[2], freg[2], vreg[2];
        auto prefetch = [&](int ci) {
#pragma unroll
            for (int i = 0; i < 2; ++i) { const int p = tid + 512 * i, row = p >> 4, dg = p & 15; const size_t ro = (size_t)grow(ci, row) * 10240;
                qreg[i] = *(const u32x4*)(PZ + ro + hd * 128 + dg * 8); freg[i] = *(const u32x4*)(PZ + ro + fcol + dg * 8); }
#pragma unroll
            for (int i = 0; i < 2; ++i) { const int p = tid + 512 * i, row = p >> 4, dg = p & 15; vreg[i] = *(const u32x4*)(PZ + (size_t)grow(ci, row) * 10240 + 6144 + hd * 128 + dg * 8); }
        };
        prefetch(0);
        for (int ci = 0; ci < 36; ++ci) {
            __syncthreads();
            f32x4 lnv[4]; int ln_rl = ln_round * ln_ngw + ln_gw; bool ln_do = false;
            if (lnl >= 0 && (ci & 3) == 0) { ln_do = ln_row_load(P, lnb0, ln_rows, ln_rl, lane, lnv); ++ln_round; }
            if (ci > 0) {
                const int ct = w >> 1;
#pragma unroll
                for (int x = 0; x < 2; ++x)
#pragma unroll
                    for (int gq = 0; gq < 4; ++gq) {
                        u32x2 o; o.x = pk2(sacc[x][4 * gq], sacc[x][4 * gq + 1]); o.y = pk2(sacc[x][4 * gq + 2], sacc[x][4 * gq + 3]);
                        *(LAS u32x2*)(ST + (32 * (2 * (w & 1) + x) + r) * 136 + 32 * ct + 8 * gq + 4 * h) = o;
                    }
            }
#pragma unroll
            for (int i = 0; i < 2; ++i) { const int p = tid + 512 * i, row = p >> 4, dg = p & 15; *(LAS u32x4*)(QS + row * 136 + dg * 8) = qreg[i]; *(LAS u32x4*)(KS + row * 136 + dg * 8) = freg[i]; }
#pragma unroll
            for (int i = 0; i < 2; ++i) { const int p = tid + 512 * i, row = p >> 4, dg = p & 15; *(LAS u32x4*)(VR + row * 160 + dg * 8) = vreg[i]; }
            __syncthreads();
            if (ci + 1 < 36) prefetch(ci + 1);
            f32x2 qv[8], kv[8], cum[8];
            {
                f32x2 run = {1.f, 1.f};
#pragma unroll
                for (int j = 0; j < 8; ++j) {
                    const int tau = seg * 8 + j;
                    const unsigned qq = *(const LAS unsigned*)(QS + tau * 136 + c0), ff = *(const LAS unsigned*)(KS + tau * 136 + c0);
                    qv[j] = (f32x2){bflo(qq), bfhi(qq)};
                    const f32x2 sg = {sigmoidf_(bflo(ff)), sigmoidf_(bfhi(ff))};
                    const f32x2 f = lb2 + (1.0f - lb2) * sg;
                    kv[j] = 1.0f - f; run = run * f; cum[j] = run;
                }
                *(LAS f32x2*)(TOT + seg * 128 + c0) = run;
            }
            __syncthreads();
            {
                f32x2 pre = {1.f, 1.f}, blast = {1.f, 1.f};
#pragma unroll
                for (int sgm = 0; sgm < 8; ++sgm) {
                    const f32x2 t = *(const LAS f32x2*)(TOT + sgm * 128 + c0);
                    if (sgm < seg) pre = pre * t;
                    blast = blast * t;
                }
                if (seg == 0) *(LAS f32x2*)(EB + c0) = blast;
                f32x2 kd[8];
#pragma unroll
                for (int j = 0; j < 8; ++j) {
                    const int tau = seg * 8 + j; const f32x2 cp = pre * cum[j]; const f32x2 icp = {__builtin_amdgcn_rcpf(cp.x), __builtin_amdgcn_rcpf(cp.y)};
                    const f32x2 a = qv[j] * cp, b = kv[j] * icp;
                    *(LAS unsigned*)(QS + tau * 136 + c0) = pk2(a.x, a.y);
                    *(LAS unsigned*)(KS + tau * 136 + c0) = pk2(b.x, b.y);
                    kd[j] = b * blast;
                }
                u32x4 k0, k1; k0.x = pk2(kd[0].x, kd[1].x); k0.y = pk2(kd[2].x, kd[3].x); k0.z = pk2(kd[4].x, kd[5].x); k0.w = pk2(kd[6].x, kd[7].x);
                k1.x = pk2(kd[0].y, kd[1].y); k1.y = pk2(kd[2].y, kd[3].y); k1.z = pk2(kd[4].y, kd[5].y); k1.w = pk2(kd[6].y, kd[7].y);
                *(LAS u32x4*)(KDT + c0 * 72 + seg * 8) = k0; *(LAS u32x4*)(KDT + (c0 + 1) * 72 + seg * 8) = k1;
            }
            __syncthreads();
            {
                const int dt = w & 3, tt = w >> 2;
                f32x16 oacc;
#pragma unroll
                for (int i = 0; i < 16; ++i) oacc[i] = 0.f;
                bf16x8 qb[8];
#pragma unroll
                for (int s = 0; s < 8; ++s) qb[s] = *(const LAS bf16x8*)(QS + (32 * tt + r) * 136 + 16 * s + 8 * h);
#pragma unroll
                for (int st = 0; st < 2; ++st) {
                    if (st <= tt) {
                        f32x16 x;
#pragma unroll
                        for (int i = 0; i < 16; ++i) x[i] = 0.f;
                        bf16x8 ka[8];
#pragma unroll
                        for (int s = 0; s < 8; ++s) ka[s] = *(const LAS bf16x8*)(KS + (32 * st + r) * 136 + 16 * s + 8 * h);
                        __builtin_amdgcn_sched_barrier(0);
#pragma unroll
                        for (int s = 0; s < 8; ++s) x = MFMA32(ka[s], qb[s], x);
                        if (st == tt) {
#pragma unroll
                            for (int i = 0; i < 16; ++i) if (crow(i, h) > r) x[i] = 0.f;
                        }
#pragma unroll
                        for (int s = 0; s < 2; ++s) {
                            u32x4 pw; pw.x = pk2(x[8 * s], x[8 * s + 1]); pw.y = pk2(x[8 * s + 2], x[8 * s + 3]); pw.z = pk2(x[8 * s + 4], x[8 * s + 5]); pw.w = pk2(x[8 * s + 6], x[8 * s + 7]);
                            const LAS bf16_t* vb = VR + (32 * st + 16 * s + 4 * h + ((lane & 15) >> 2)) * 160 + 32 * dt + 16 * ((lane >> 4) & 1) + 4 * (lane & 3);
                            const s16x4 lo = LDS_TR16(vb), hi = LDS_TR16(vb + 8 * 160);
                            oacc = MFMA32(__builtin_shufflevector(lo, hi, 0, 1, 2, 3, 4, 5, 6, 7), __builtin_bit_cast(bf16x8, pw), oacc);
                        }
                    }
                }
                {
                    bf16x8 sa[8];
#pragma unroll
                    for (int s = 0; s < 8; ++s) sa[s] = *(const LAS bf16x8*)(ST + (32 * dt + r) * 136 + 16 * s + 8 * h);
                    __builtin_amdgcn_sched_barrier(0);
#pragma unroll
                    for (int s = 0; s < 8; ++s) oacc = MFMA32(sa[s], qb[s], oacc);
                }
                LAS bf16_t* OLh = (LAS bf16_t*)(lds + 113152) + w * (32 * 40);
#pragma unroll
                for (int gq = 0; gq < 4; ++gq) {
                    u32x2 o; o.x = pk2(oacc[4 * gq], oacc[4 * gq + 1]); o.y = pk2(oacc[4 * gq + 2], oacc[4 * gq + 3]);
                    *(LAS u32x2*)(OLh + r * 40 + 8 * gq + 4 * h) = o;
                }
                asm volatile("s_waitcnt lgkmcnt(0)" ::: "memory");
                bf16_t* ob = dir ? (bf16_t*)(P.ws + OFF_OB) : (bf16_t*)(P.ws + OFF_AOUT);
#pragma unroll
                for (int k = 0; k < 2; ++k) {
                    const int p = lane + 64 * k, row = p >> 2, pc = p & 3;
                    const u32x4 v = *(const LAS u32x4*)(OLh + row * 40 + pc * 8);
                    *(u32x4*)(ob + (size_t)grow(ci, 32 * tt + row) * 2048 + hd * 128 + 32 * dt + pc * 8) = v;
                }
            }
            {
                const int ct = w >> 1;
                f32x4 eb[4];
#pragma unroll
                for (int gq = 0; gq < 4; ++gq) eb[gq] = *(const LAS f32x4*)(EB + 32 * ct + 8 * gq + 4 * h);
                bf16x8 ka[4], vb2[2][4];
#pragma unroll
                for (int s = 0; s < 4; ++s) {
                    ka[s] = *(const LAS bf16x8*)(KDT + (32 * ct + r) * 72 + 16 * s + 8 * h);
#pragma unroll
                    for (int x = 0; x < 2; ++x) {
                        const LAS bf16_t* vb = VR + (16 * s + 8 * h + ((lane & 15) >> 2)) * 160 + 32 * (2 * (w & 1) + x) + 16 * ((lane >> 4) & 1) + 4 * (lane & 3);
                        const s16x4 blo = LDS_TR16(vb), bhi = LDS_TR16(vb + 4 * 160);
                        vb2[x][s] = __builtin_shufflevector(blo, bhi, 0, 1, 2, 3, 4, 5, 6, 7);
                    }
                }
                __builtin_amdgcn_sched_barrier(0);
#pragma unroll
                for (int i = 0; i < 16; ++i) { const float e = eb[i >> 2][i & 3]; sacc[0][i] *= e; sacc[1][i] *= e; }
#pragma unroll
                for (int s = 0; s < 4; ++s)
#pragma unroll
                    for (int x = 0; x < 2; ++x) sacc[x] = MFMA32(ka[s], vb2[x][s], sacc[x]);
            }
            if (ln_do) ln_row_finish(P, lnl, lnb0, ln_rl, lane, lnv);
        }
        __syncthreads();
    }
}

DI void phase_hgcombine(PRef P) {
    const bf16_t* PZ = (const bf16_t*)(P.ws + OFF_PZ);
    bf16_t* AO = (bf16_t*)(P.ws + OFF_AOUT);
    const bf16_t* OB = (const bf16_t*)(P.ws + OFF_OB);
    const float* gn = P.in[IN_HGNG];
    const size_t GT = (size_t)gridDim.x * 512, NIT = (size_t)CHR * 256;
    for (size_t i0 = (size_t)blockIdx.x * 512 + opaque_tid(); i0 < NIT; i0 += 4 * GT) {
        u32x4 a[4], b[4], z[4];
#pragma unroll
        for (int k = 0; k < 4; ++k) {
            const size_t i = i0 + k * GT;
            if (i < NIT) { const int row = (int)(i >> 8), c = (int)(i & 255) * 8;
                a[k] = *(const u32x4*)(AO + (size_t)row * 2048 + c); b[k] = *(const u32x4*)(OB + (size_t)row * 2048 + c); z[k] = *(const u32x4*)(PZ + (size_t)row * 10240 + 8192 + c); }
            else { a[k] = (u32x4){0u, 0u, 0u, 0u}; b[k] = a[k]; z[k] = a[k]; }
        }
#pragma unroll
        for (int k = 0; k < 4; ++k) {
            const size_t i = i0 + k * GT;
            const int row = (int)(i >> 8), c = (int)(i & 255) * 8;
            float o[8];
            o[0] = bflo(a[k].x) + bflo(b[k].x); o[1] = bfhi(a[k].x) + bfhi(b[k].x); o[2] = bflo(a[k].y) + bflo(b[k].y); o[3] = bfhi(a[k].y) + bfhi(b[k].y);
            o[4] = bflo(a[k].z) + bflo(b[k].z); o[5] = bfhi(a[k].z) + bfhi(b[k].z); o[6] = bflo(a[k].w) + bflo(b[k].w); o[7] = bfhi(a[k].w) + bfhi(b[k].w);
            float ss = 0.f;
#pragma unroll
            for (int j = 0; j < 8; ++j) ss += o[j] * o[j];
            ss += __shfl_xor(ss, 1); ss += __shfl_xor(ss, 2); ss += __shfl_xor(ss, 4); ss += __shfl_xor(ss, 8);
            if (i < NIT) {
                const float rs = rsqrtf(ss * (1.0f / 128.0f) + 1e-5f);
                const f32x4 g0 = *(const f32x4*)(gn + c), g1 = *(const f32x4*)(gn + c + 4);
                const float zz[8] = {bflo(z[k].x), bfhi(z[k].x), bflo(z[k].y), bfhi(z[k].y), bflo(z[k].z), bfhi(z[k].z), bflo(z[k].w), bfhi(z[k].w)};
                float q[8];
#pragma unroll
                for (int j = 0; j < 8; ++j) q[j] = o[j] * rs * (j < 4 ? g0[j] : g1[j - 4]) * siluf_(zz[j]);
                u32x4 wv; wv.x = pk2(q[0], q[1]); wv.y = pk2(q[2], q[3]); wv.z = pk2(q[4], q[5]); wv.w = pk2(q[6], q[7]);
                *(u32x4*)(AO + (size_t)row * 2048 + c) = wv;
            }
        }
    }
}

#define XB_TMO      128
#define XB_XCNT(j)  (256  + 64 * (j))
#define XB_XSUB(j)  (1280 + 64 * (j))
#define XB_XGEN(j)  (2304 + 64 * (j))
#define XB_TOP      3328
#define XB_TOPGEN   3392
#define XCD_BAR_WORDS 3456
#define XB_SPIN_CAP (1u << 18)
DI unsigned xb_ld(unsigned* p) { return __hip_atomic_load(p, __ATOMIC_RELAXED, __HIP_MEMORY_SCOPE_AGENT); }
DI unsigned xb_add(unsigned* p, unsigned v) { return __hip_atomic_fetch_add(p, v, __ATOMIC_RELAXED, __HIP_MEMORY_SCOPE_AGENT); }
DI unsigned xb_xcc_id() { return (unsigned)__builtin_amdgcn_s_getreg((3 << 11) | 20) & 0xFu; }
#define XB_SPIN(cond, bar) do { unsigned _sp = 0; while (cond) { __builtin_amdgcn_s_sleep(1); \
    if ((++_sp & 255u) == 0u) { if (xb_ld(&(bar)[XB_TMO])) break; if (_sp > XB_SPIN_CAP) { atomicAdd(&(bar)[XB_TMO], 1u); break; } } } } while (0)
struct XcdBarrier { unsigned* bar; unsigned x; volatile LAS unsigned* st; };
DI XcdBarrier xcd_barrier_post(unsigned* bar, volatile LAS unsigned* st) {
    XcdBarrier b; b.bar = bar; b.x = xb_xcc_id(); b.st = st;
    if (threadIdx.x == 0) (void)xb_add(&bar[XB_XCNT(b.x)], 1u);
    return b;
}
DI void xcd_barrier_complete(unsigned* bar, unsigned x, unsigned& nloc, unsigned& nx) {
    const unsigned G = gridDim.x * gridDim.y * gridDim.z;
    unsigned sum, cnt, mine, sp = 0u;
    for (;;) {
        sum = 0u; cnt = 0u; mine = 0u;
#pragma unroll
        for (unsigned j = 0; j < 16; ++j) { const unsigned c = xb_ld(&bar[XB_XCNT(j)]); sum += c; cnt += (c > 0u) ? 1u : 0u; mine = (j == x) ? c : mine; }
        if (sum == G) break;
        __builtin_amdgcn_s_sleep(1);
        if ((++sp & 255u) == 0u) { if (xb_ld(&bar[XB_TMO])) break; if (sp > XB_SPIN_CAP) { atomicAdd(&bar[XB_TMO], 1u); break; } }
    }
    nloc = mine > 0u ? mine : 1u; nx = cnt > 0u ? cnt : 1u;
}
DI void xcd_barrier(unsigned* bar_, volatile LAS unsigned* st_) {
    XcdBarrier b; b.bar = bar_; b.x = xb_xcc_id(); b.st = st_;
    asm volatile("s_waitcnt vmcnt(0)" ::: "memory");
    __syncthreads();
    if (threadIdx.x == 0) {
        unsigned* bar = b.bar;
        __builtin_amdgcn_s_waitcnt(0);
        unsigned nloc = b.st[0], nx = b.st[1];
        if (nloc == 0u) { xcd_barrier_complete(bar, b.x, nloc, nx); b.st[0] = nloc; b.st[1] = nx; }
        const unsigned old = xb_add(&bar[XB_XSUB(b.x)], 1u);
        const unsigned gen = old / nloc;
        if (old + 1u == (gen + 1u) * nloc) {
            __builtin_amdgcn_fence(__ATOMIC_RELEASE, "agent");
            asm volatile("s_waitcnt vmcnt(0)" ::: "memory");
            const unsigned og = xb_add(&bar[XB_TOP], 1u);
            const unsigned tg = og / nx;
            if (og + 1u == (tg + 1u) * nx) xb_add(&bar[XB_TOPGEN], 1u);
            else XB_SPIN(xb_ld(&bar[XB_TOPGEN]) == tg, bar);
            __builtin_amdgcn_fence(__ATOMIC_ACQUIRE, "agent");
            xb_add(&bar[XB_XGEN(b.x)], 1u);
            asm volatile("s_waitcnt vmcnt(0)" ::: "memory");
        } else {
            XB_SPIN(xb_ld(&bar[XB_XGEN(b.x)]) == gen, bar);
            __builtin_amdgcn_fence(__ATOMIC_ACQUIRE, "agent");
            asm volatile("s_waitcnt vmcnt(0)" ::: "memory");
        }
    }
    __syncthreads();
}

DI void stage_params(int t, int& layer, int& b0, int& nb) {
    asm volatile("" : "+s"(t));
    if (t < 2) { layer = 0; nb = 16; b0 = 16 * t; } else if (t < 6) { layer = 1; nb = 8; b0 = 8 * (t - 2); } else if (t < 10) { layer = 2; nb = 8; b0 = 8 * (t - 6); } else { layer = 3; nb = 16; b0 = 16 * (t - 10); }
}
__global__ void __launch_bounds__(512, 2) mega(Params P) {
    extern __shared__ __attribute__((aligned(16))) unsigned char lds_raw[];
    LAS unsigned char* lds = (LAS unsigned char*)lds_raw;
    cg::grid_group grid = cg::this_grid();
    const int G = gridDim.x, c = blockIdx.x;
    const __attribute__((address_space(4))) Params* kp = (const __attribute__((address_space(4))) Params*)__builtin_amdgcn_kernarg_segment_ptr();
#define PK (*({ const __attribute__((address_space(4))) Params* _p = kp; asm volatile("" : "+s"(_p)); _p; }))
    unsigned char* ws = PK.ws;
    bf16_t* Hb = (bf16_t*)(ws + OFF_H);
    bf16_t* PZ = (bf16_t*)(ws + OFF_PZ);
    bf16_t* AO = (bf16_t*)(ws + OFF_AOUT);
    const float* mods = (const float*)(ws + OFF_MODS);

    volatile LAS unsigned* bst = (volatile LAS unsigned*)(lds + LDS_BYTES - 16);
    if (threadIdx.x == 0) { bst[0] = 0u; bst[1] = 0u; }
    __syncthreads();
    (void)xcd_barrier_post((unsigned*)(PK.ws + OFF_BAR), bst);
#define GRID_BARRIER() xcd_barrier((unsigned*)(PK.ws + OFF_BAR), (volatile LAS unsigned*)(lds + LDS_BYTES - 16))
    phase_prologue(PK, lds);
    grid.sync();
    phase_modulate0(PK);
    GRID_BARRIER();
    constexpr int NSTAGE = 12;
#pragma unroll 1
    for (int s = 0; s <= NSTAGE; ++s) {
        int layer, b0, nb, pl, pb0, pnb;
        { const int t = s; if (t < 2) { layer = 0; nb = 16; b0 = 16 * t; } else if (t < 6) { layer = 1; nb = 8; b0 = 8 * (t - 2); } else if (t < 10) { layer = 2; nb = 8; b0 = 8 * (t - 6); } else { layer = 3; nb = 16; b0 = 16 * (t - 10); } }
        { const int t = s - 1; if (t < 2) { pl = 0; pnb = 16; pb0 = 16 * t; } else if (t < 6) { pl = 1; pnb = 8; pb0 = 8 * (t - 2); } else if (t < 10) { pl = 2; pnb = 8; pb0 = 8 * (t - 6); } else { pl = 3; pnb = 16; pb0 = 16 * (t - 10); } }
        const int kind = layer % 3;
        pg8::Sched S;
        int u2 = 0;
        if (s >= 1) {
            pg8::Gemm g{AO, (const bf16_t*)(ws + OFF_WT_OUT) + (size_t)pl * 1024 * 2048, 2048, 2048, 2048, 0, 0};
            Epi<EP_RES> e{};
            e.xin_lat = pl == 0 ? PK.in[IN_X] : PK.out; e.xin_ctx = pl == 0 ? PK.in[IN_CTX] : (const float*)(ws + OFF_XCTX);
            e.xout_lat = PK.out; e.xout_ctx = (float*)(ws + OFF_XCTX); e.gate = mods + (size_t)pl * 33 * 3072 + 2048; e.chunk = pb0; e.alpha = 1.681792830507429f;
            if (pl == 3) { S.init(pnb * 8, 4, 1, G, c, 1); u2 = pnb * 32; } else { S.init(pnb * 9, 4, 1, G, c, 0); u2 = pnb * 36; }
            pg8::gemm_phase(lds, g, S, e);
        }
        if (s < NSTAGE) {
            const bf16_t* Hc = Hb + (size_t)b0 * TPB * D;
            const int nN = kind == 0 ? 20 : (kind == 1 ? 16 : 40);
            const int u1 = nb * 9 * nN, base = u2 / G, rem = u2 % G, cmax = (2 * u2 + u1 + G - 1) / G;
            int R = cmax - 2 * (base + 1); if (R < 0) R = 0;
            if (kind == 0) {
                const int aj = layer / 3;
                pg8::Gemm g{Hc, (const bf16_t*)(ws + OFF_WT_ATT) + (size_t)aj * 5120 * 1024, 1024, 1024, 1024, 0, 0};
                Epi<EP_ROPE> e{}; e.O = PZ; e.ldc = 5120; e.rope = (const float*)(ws + OFF_ROPE);
                if (layer == 3) {
                    const int u1l = nb * 8 * nN, cm = (2 * u2 + u1l + G - 1) / G; int Rl = cm - 2 * (u2 / G + 1); if (Rl < 0) Rl = 0;
                    S.init(nb * 8, nN, 1, G, c, 1, Rl, rem); pg8::gemm_phase(lds, g, S, e);
                    S.init(nb, 4, 1, G, c - G / 2, 2); S.pn0 = 8; pg8::gemm_phase(lds, g, S, e);
                } else { S.init(nb * 9, nN, 1, G, c, 0, R, rem); pg8::gemm_phase(lds, g, S, e); }
            } else if (kind == 1) {
                pg8::Gemm g{Hc, (const bf16_t*)(ws + OFF_WT_S5), 1024, 1024, 1024, 0, 0};
                Epi<EP_S5IN> e{}; e.O = PZ; e.ldc = 4096; e.UH = (bf16_t*)(ws + OFF_UH);
                S.init(nb * 9, nN, 1, G, c, 0, R, rem); pg8::gemm_phase(lds, g, S, e);
            } else {
                pg8::Gemm g{Hc, (const bf16_t*)(ws + OFF_WT_HG), 1024, 1024, 1024, 0, 0};
                Epi<EP_PLAIN> e{}; e.O = PZ; e.ldc = 10240;
                S.init(nb * 9, nN, 1, G, c, 0, R, rem); pg8::gemm_phase(lds, g, S, e);
            }
        }
        GRID_BARRIER();
        if (s >= 1 && !(s < NSTAGE && (kind == 1 || kind == 2))) { int l2, b2, n2; stage_params(s - 1, l2, b2, n2); phase_ln(PK, l2, b2, n2); }
        if (s < NSTAGE) {
            if (kind == 0) {
                phase_attn(PK, lds, layer / 3, layer == 3, nb);
            } else if (kind == 1) {
                { pg8::Gemm g{(const bf16_t*)(ws + OFF_UH), (const bf16_t*)(ws + OFF_BT1), 512, 256, 256, 1280L * 512, 256L * 256};
                  Epi<EP_PLAIN> e{}; e.O = (bf16_t*)(ws + OFF_HLOC); e.zsC = 1280L * 256; e.ldc = 256;
                  S.init(5, 1, 128, G, c, 0); pg8::gemm_phase(lds, g, S, e); }
                GRID_BARRIER();
                phase_s5scan(PK);
                GRID_BARRIER();
                { pg8::Gemm g{(const bf16_t*)(ws + OFF_UH), (const bf16_t*)(ws + OFF_BT3), 512, 512, 512, 1280L * 512, 256L * 512};
                  Epi<EP_S5OUT> e{}; e.O = PZ;
                  S.init(5, 1, 128, G, c, 0); pg8::gemm_phase(lds, g, S, e); }
                GRID_BARRIER();
                { pg8::Gemm g{PZ, (const bf16_t*)(ws + OFF_WT_GLU), 4096, 2048, 2048, 0, 0};
                  Epi<EP_GLU> e{}; e.O = AO; e.ldc = 2048; e.PZ = PZ; e.bias = PK.in[IN_GLUB];
                  const int heavy = (72 * 8) % G;
                  if (s >= 1) { int l2, b2, n2; stage_params(s - 1, l2, b2, n2); if (heavy > 0 && heavy < G) phase_ln(PK, l2, b2, n2, heavy, G - heavy); else phase_ln(PK, l2, b2, n2); }
                  S.init(72, 8, 1, G, c, 0); pg8::gemm_phase(lds, g, S, e); }
            } else {
                { int l2, b2, n2; stage_params(s - 1, l2, b2, n2);
                  const bool emb = (G * 8 * 9 == n2 * TPB);
                  if (s >= 1 && !emb) phase_ln(PK, l2, b2, n2);
                  phase_hgrn(PK, lds, layer, (s >= 1 && emb) ? l2 : -1, b2, n2); }
                GRID_BARRIER();
                phase_hgcombine(PK);
            }
            GRID_BARRIER();
        }
    }
}

extern "C" void kernel_launch(void* const* d_in, const int* in_sizes, int n_in, void* d_out, int out_size,
                              void* d_ws, size_t ws_size, hipStream_t stream) {
    static int grid_blocks = 0;
    if (!grid_blocks) {
        if (n_in != 25 || ws_size < WS_END) { fprintf(stderr, "kernel_launch: unexpected inputs (n_in %d, ws %zu < %zu); nothing launched\n", n_in, ws_size, (size_t)WS_END); grid_blocks = -1; return; }
        int dev = 0, cus = 0, per_cu = 0;
        (void)hipGetDevice(&dev);
        (void)hipDeviceGetAttribute(&cus, hipDeviceAttributeMultiprocessorCount, dev);
        (void)hipFuncSetAttribute((const void*)mega, hipFuncAttributeMaxDynamicSharedMemorySize, LDS_BYTES);
        (void)hipOccupancyMaxActiveBlocksPerMultiprocessor(&per_cu, (const void*)mega, 512, LDS_BYTES);
        if (per_cu < 1) per_cu = 1;
        grid_blocks = cus * per_cu;
    }
    if (grid_blocks < 0) return;
    Params p{};
    for (int i = 0; i < 25; ++i) p.in[i] = (const float*)d_in[i];
    p.out = (float*)d_out; p.ws = (unsigned char*)d_ws;
    (void)hipMemsetAsync((unsigned char*)d_ws + OFF_BAR, 0, 16384, stream);
    void* args[] = {&p};
    hipError_t e = hipLaunchCooperativeKernel((const void*)mega, dim3(grid_blocks), dim3(512), args, LDS_BYTES, stream);
    if (e != hipSuccess) fprintf(stderr, "cooperative launch failed: %s (grid %d)\n", hipGetErrorString(e), grid_blocks);
}
```

```cpp
#include <hip/hip_runtime.h>
#include <hip/hip_cooperative_groups.h>
#include <cstdio>
namespace cg = cooperative_groups;

#define DI __device__ __forceinline__
#define LAS __attribute__((address_space(3)))
typedef unsigned short bf16_t;
typedef short bf16x8 __attribute__((ext_vector_type(8)));
typedef float f32x2 __attribute__((ext_vector_type(2)));
typedef float f32x4 __attribute__((ext_vector_type(4)));
typedef float f32x16 __attribute__((ext_vector_type(16)));
typedef unsigned u32x2 __attribute__((ext_vector_type(2)));
typedef unsigned u32x4 __attribute__((ext_vector_type(4)));
typedef __bf16 bfv2 __attribute__((ext_vector_type(2)));
typedef short s16x4 __attribute__((ext_vector_type(4)));
#define LDS_TR16(ptr) __builtin_amdgcn_ds_read_tr16_b64_v4i16((LAS s16x4*)(ptr))

constexpr int D = 1024, E = 2048, TPB = 2304, NB = 8, CHR = NB * TPB, NCHUNK = 4;
constexpr int IN_X = 0, IN_C = 1, IN_CTX = 2, IN_CCTX = 3, IN_ADAW = 4, IN_ADAB = 5, IN_LNG = 6, IN_LNB = 7, IN_WOUT = 8, IN_ATTW = 9, IN_SINK = 10,
              IN_S5W = 11, IN_LRE = 12, IN_LIM = 13, IN_LSTEP = 14, IN_BRE = 15, IN_BIM = 16, IN_CRE = 17, IN_CIM = 18, IN_S5D = 19, IN_GLUW = 20,
              IN_GLUB = 21, IN_HGW = 22, IN_HGLB = 23, IN_HGNG = 24;
constexpr size_t OFF_WT_ATT = 0;
constexpr size_t OFF_WT_S5 = OFF_WT_ATT + 2ull * 5120 * 1024 * 2;
constexpr size_t OFF_WT_HG = OFF_WT_S5 + 4096ull * 1024 * 2;
constexpr size_t OFF_WT_OUT = OFF_WT_HG + 10240ull * 1024 * 2;
constexpr size_t OFF_WT_GLU = OFF_WT_OUT + 4ull * 1024 * 2048 * 2;
constexpr size_t OFF_MODS = OFF_WT_GLU + 2048ull * 2048 * 2;
constexpr size_t OFF_ROPE = OFF_MODS + 2097152;
constexpr size_t OFF_XCTX = OFF_ROPE + 65536;
constexpr size_t OFF_H = OFF_XCTX + 8192ull * 1024 * 4;
constexpr size_t OFF_BT1 = OFF_H + 73728ull * 1024 * 2;
constexpr size_t OFF_BT3 = OFF_BT1 + 128ull * 256 * 256 * 2;
constexpr size_t OFF_AOUT = OFF_BT3 + 128ull * 256 * 512 * 2;
constexpr size_t OFF_PZ = OFF_AOUT + 2 * (size_t)CHR * 2048 * 2;
constexpr size_t OFF_UH = OFF_PZ + (size_t)CHR * 4096 * 2;
constexpr size_t OFF_OB = OFF_PZ + (size_t)CHR * 10240 * 2;
constexpr size_t OFF_HLOC = OFF_UH + 128ull * 1280 * 512 * 2;
constexpr size_t OFF_BAR = OFF_HLOC + 128ull * 1280 * 256 * 4;
constexpr size_t WS_END = OFF_BAR + 16384;
static_assert(OFF_OB + (size_t)CHR * 2048 * 2 <= OFF_BAR && OFF_PZ + 2 * (size_t)CHR * 5120 * 2 <= OFF_BAR, "ws");
constexpr int LDS_BYTES = 160 * 1024;

struct Params { const float* in[25]; float* out; unsigned char* ws; };
typedef const __attribute__((address_space(4))) Params& PRef;

DI unsigned pk2(float a, float b) { f32x2 v = {a, b}; bfv2 r = __builtin_convertvector(v, bfv2); return __builtin_bit_cast(unsigned, r); }
DI float bflo(unsigned u) { return __uint_as_float(u << 16); }
DI float bfhi(unsigned u) { return __uint_as_float(u & 0xffff0000u); }
DI float bf2f(bf16_t u) { return __uint_as_float(((unsigned)u) << 16); }
DI float sigmoidf_(float v) { return __builtin_amdgcn_rcpf(1.0f + __expf(-v)); }
DI float siluf_(float v) { return v * sigmoidf_(v); }
DI float gelu_tanh(float x) { return x * sigmoidf_(1.5957691216f * (x + 0.044715f * x * x * x)); }
DI float glu_gate(float g, float u, float z) { return g * z * __builtin_amdgcn_rcpf((1.0f + __expf(-u)) * (1.0f + __expf(-z))); }
DI float xhalf_max(float v) { const auto r = __builtin_amdgcn_permlane32_swap(__float_as_uint(v), __float_as_uint(v), false, false); return fmaxf(__uint_as_float(r[0]), __uint_as_float(r[1])); }
DI float xhalf_sum(float v) { const auto r = __builtin_amdgcn_permlane32_swap(__float_as_uint(v), __float_as_uint(v), false, false); return __uint_as_float(r[0]) + __uint_as_float(r[1]); }
DI int opaque_tid() { int t = threadIdx.x; asm volatile("" : "+v"(t)); return t; }
DI int crow(int reg, int h) { return (reg & 3) + 8 * (reg >> 2) + 4 * h; }
#define MFMA32(a, b, c) __builtin_amdgcn_mfma_f32_32x32x16_bf16((a), (b), (c), 0, 0, 0)

namespace pg8 {
constexpr int BM = 256, BK = 64, HALF = 128, HTB = HALF * BK * 2, STAGE_BYTES = 8 * HTB, NXCD = 8, WGM = 4;
DI int lds_byte(int r, int c) { const int st = (r >> 4) * 2 + (c >> 5), rr = r & 15, cc = c & 31, ob = rr * 64 + cc * 2; return st * 1024 + (ob ^ (((ob >> 9) & 1) << 5)); }
DI void stage_rc(int b, int& R, int& C) { const int st = b / 1024, sb = b % 1024, swz = sb ^ (((sb >> 9) & 1) << 5); R = (st >> 1) * 16 + swz / 64; C = (st & 1) * 32 + (swz % 64) / 2; }
DI int perm32(int rho) { const int n = rho >> 4, i = rho & 15; return 8 * (i >> 2) + 4 * n + (i & 3); }
struct Unit { int pm, pn, z; };
struct Gemm { const bf16_t* A; const bf16_t* Bt; int lda, ldb, K; long zsA, zsB; };
struct Sched {
    int nM, nN, per, total, G, c, skipctx, R, rem, pn0 = 0;
    DI void init(int nM_, int nN_, int nZ_, int G_, int c_, int skipctx_, int R_ = 0x3fffffff, int rem_ = 0) { nM = nM_; nN = nN_; per = nM_ * nN_; total = per * nZ_; G = G_; c = c_; skipctx = skipctx_; R = R_; rem = rem_; pn0 = 0; }
    DI bool next(int i, Unit& u) const {
        if (c < 0) return false;
        long L;
        if (i < R || rem == 0) L = (long)i * G + c;
        else { if (c < rem) return false; L = (long)R * G + (long)(i - R) * (G - rem) + (c - rem); }
        if (L >= total) return false;
        const int z = (int)(L / per); int wgid = (int)(L % per); const int nwg = per;
        { const int q = nwg / NXCD, r = nwg % NXCD, xcd = wgid % NXCD, off = wgid / NXCD; wgid = (xcd < r ? xcd * (q + 1) : r * (q + 1) + (xcd - r) * q) + off; }
        const int nig = WGM * nN, gid = wgid / nig, fm = gid * WGM, gsz = (nM - fm) < WGM ? (nM - fm) : WGM;
        int pm = fm + ((wgid % nig) % gsz); const int pn = (wgid % nig) / gsz;
        if (skipctx == 1) pm = (pm >> 3) * 9 + 1 + (pm & 7); else if (skipctx == 2) pm = pm * 9;
        u.pm = pm; u.pn = pn + pn0; u.z = z; return true;
    }
};

template <class Epi>
DI void gemm_phase(LAS unsigned char* lds, const Gemm g, const Sched& S, const Epi& E) {
    const int tid = opaque_tid(), wid = __builtin_amdgcn_readfirstlane(tid >> 6), lane = tid & 63, wr = wid >> 2, wc = wid & 3, fr = lane & 15, fq = lane >> 4;
    const int K = g.K, nt = K / BK;
    unsigned voffA[2], voffB[2];
#pragma unroll
    for (int i = 0; i < 2; ++i) { int R, C; stage_rc(tid * 16 + i * 8192, R, C); const int Rb = Epi::PERM ? ((R & ~31) + perm32(R & 31)) : R;
        voffA[i] = (unsigned)(R * g.lda + C) * 2u; voffB[i] = (unsigned)(Rb * g.ldb + C) * 2u; }
    const size_t kstep = (size_t)(BK * 2);
    const size_t hstepA = (size_t)HALF * g.lda * 2, hstepB = (size_t)HALF * g.ldb * 2;
    const size_t tstepA = 2 * hstepA, tstepB = 2 * hstepB;
    const unsigned ldsw = (unsigned)wid * 1024u;
    const int aoff = lds_byte(wr * 64 + fr, fq * 8), boff = lds_byte(wc * 32 + fr, fq * 8);
#define PG8_SA(b, h) (((b) * 2 + (h)) * HTB)
#define PG8_SB(b, h) ((4 + (b) * 2 + (h)) * HTB)
#define PG8_STAGE(bufoff, gbase, voff) do { _Pragma("unroll") for (int _i = 0; _i < 2; ++_i) \
        __builtin_amdgcn_global_load_lds((const unsigned*)((const char*)(gbase) + (voff)[_i]), (LAS unsigned*)(lds + (bufoff) + ldsw + _i * 8192), 16, 0, 0); } while (0)
#define PG8_LDA(dst, b, h) do { _Pragma("unroll") for (int m = 0; m < 4; ++m) _Pragma("unroll") for (int k = 0; k < 2; ++k) dst[m][k] = *(const LAS bf16x8*)(lds + PG8_SA(b, h) + aoff + m * 2048 + k * 1024); } while (0)
#define PG8_LDB(dst, b, h) do { _Pragma("unroll") for (int n = 0; n < 2; ++n) _Pragma("unroll") for (int k = 0; k < 2; ++k) dst[n][k] = *(const LAS bf16x8*)(lds + PG8_SB(b, h) + boff + n * 2048 + k * 1024); } while (0)
#define PG8_MMA(ai, bj, At, Bt) do { __builtin_amdgcn_s_setprio(1); _Pragma("unroll") for (int m = 0; m < 4; ++m) _Pragma("unroll") for (int n = 0; n < 2; ++n) _Pragma("unroll") for (int k = 0; k < 2; ++k) \
        acc[ai][bj][m][n] = __builtin_amdgcn_mfma_f32_16x16x32_bf16(Bt[n][k], At[m][k], acc[ai][bj][m][n], 0, 0, 0); __builtin_amdgcn_s_setprio(0); } while (0)
#define PG8_WAIT_V(n) asm volatile("s_waitcnt vmcnt(" #n ")" ::: "memory")
#define PG8_WAIT_L(n) asm volatile("s_waitcnt lgkmcnt(" #n ")" ::: "memory")
#define PG8_BAR __builtin_amdgcn_s_barrier()
#define PG8_SCHED __builtin_amdgcn_sched_barrier(0)
    Unit cur, nxt; int ui = 0;
    if (!S.next(0, cur)) return;
    f32x4 acc[2][2][4][2];
#pragma unroll
    for (int a = 0; a < 2; ++a)
#pragma unroll
        for (int b = 0; b < 2; ++b)
#pragma unroll
            for (int m = 0; m < 4; ++m)
#pragma unroll
                for (int n = 0; n < 2; ++n) acc[a][b][m][n] = (f32x4){0.f, 0.f, 0.f, 0.f};
    bf16x8 At[4][2], B0[2][2], B1[2][2];
    const char* cA = (const char*)g.A + (size_t)cur.z * g.zsA * 2 + (size_t)cur.pm * tstepA;
    const char* cB = (const char*)g.Bt + (size_t)cur.z * g.zsB * 2 + (size_t)cur.pn * tstepB;
    PG8_STAGE(PG8_SB(0, 0), cB, voffB); PG8_STAGE(PG8_SA(0, 0), cA, voffA); PG8_STAGE(PG8_SB(0, 1), cB + hstepB, voffB); PG8_STAGE(PG8_SA(0, 1), cA + hstepA, voffA);
    if (wr == 1) PG8_BAR;
    PG8_WAIT_V(4); PG8_BAR;
    PG8_STAGE(PG8_SB(1, 0), cB + kstep, voffB); PG8_STAGE(PG8_SA(1, 0), cA + kstep, voffA); PG8_STAGE(PG8_SB(1, 1), cB + hstepB + kstep, voffB);
    PG8_WAIT_V(6); PG8_BAR;
    for (;;) {
        const bool has_next = S.next(ui + 1, nxt);
        const char* nA = has_next ? (const char*)g.A + (size_t)nxt.z * g.zsA * 2 + (size_t)nxt.pm * tstepA : cA;
        const char* nB = has_next ? (const char*)g.Bt + (size_t)nxt.z * g.zsB * 2 + (size_t)nxt.pn * tstepB : cB;
        for (int t = 0; t < nt; t += 2) {
            const bool last = (t == nt - 2);
            const char* a1 = cA + (size_t)(t + 1) * kstep;
            const char* a2 = last ? nA : cA + (size_t)(t + 2) * kstep; const char* b2 = last ? nB : cB + (size_t)(t + 2) * kstep;
            const char* a3 = a2 + kstep; const char* b3 = b2 + kstep;
            PG8_LDB(B0, 0, 0); PG8_SCHED; PG8_LDA(At, 0, 0); PG8_STAGE(PG8_SA(1, 1), a1 + hstepA, voffA);
            PG8_WAIT_L(8); PG8_BAR; PG8_WAIT_L(0); PG8_MMA(0, 0, At, B0); PG8_BAR; PG8_SCHED;
            PG8_LDB(B1, 0, 1); PG8_STAGE(PG8_SB(0, 0), b2, voffB);
            PG8_BAR; PG8_WAIT_L(0); PG8_MMA(0, 1, At, B1); PG8_BAR;
            PG8_LDA(At, 0, 1); PG8_STAGE(PG8_SA(0, 0), a2, voffA);
            PG8_BAR; PG8_WAIT_L(0); PG8_MMA(1, 0, At, B0); PG8_BAR; PG8_SCHED;
            PG8_STAGE(PG8_SB(0, 1), b2 + hstepB, voffB);
            PG8_WAIT_V(6); PG8_BAR; PG8_MMA(1, 1, At, B1); PG8_BAR;
            PG8_LDB(B0, 1, 0); PG8_SCHED; PG8_LDA(At, 1, 0); PG8_STAGE(PG8_SA(0, 1), a2 + hstepA, voffA);
            PG8_WAIT_L(8); PG8_BAR; PG8_WAIT_L(0); PG8_MMA(0, 0, At, B0); PG8_BAR; PG8_SCHED;
            PG8_LDB(B1, 1, 1); PG8_STAGE(PG8_SB(1, 0), b3, voffB);
            PG8_BAR; PG8_WAIT_L(0); PG8_MMA(0, 1, At, B1); PG8_BAR;
            PG8_LDA(At, 1, 1); PG8_STAGE(PG8_SA(1, 0), a3, voffA);
            PG8_BAR; PG8_WAIT_L(0); PG8_MMA(1, 0, At, B0); PG8_BAR; PG8_SCHED;
            PG8_STAGE(PG8_SB(1, 1), b3 + hstepB, voffB);
            PG8_WAIT_V(6); PG8_BAR; PG8_MMA(1, 1, At, B1); PG8_BAR;
        }
        E(acc, cur, wr, wc, fr, fq);
        if (!has_next) break;
#pragma unroll
        for (int a = 0; a < 2; ++a)
#pragma unroll
            for (int b = 0; b < 2; ++b)
#pragma unroll
                for (int m = 0; m < 4; ++m)
#pragma unroll
                    for (int n = 0; n < 2; ++n) acc[a][b][m][n] = (f32x4){0.f, 0.f, 0.f, 0.f};
        cur = nxt; cA = nA; cB = nB; ++ui;
    }
    PG8_WAIT_V(0);
    if (wr == 0) PG8_BAR;
    PG8_BAR;
#undef PG8_SA
#undef PG8_SB
#undef PG8_STAGE
#undef PG8_LDA
#undef PG8_LDB
#undef PG8_MMA
#undef PG8_WAIT_V
#undef PG8_WAIT_L
#undef PG8_BAR
#undef PG8_SCHED
}
}
using pg8::Unit;

enum { EP_PLAIN = 0, EP_ROPE = 1, EP_S5IN = 2, EP_F32 = 3, EP_S5OUT = 4, EP_GLU = 5, EP_RES = 6 };
template <int MODE> struct Epi {
    static constexpr bool PERM = (MODE != EP_F32 && MODE != EP_RES);
    bf16_t* O; int ldc;
    const float* rope;
    bf16_t* UH;
    float* C32; long zsC;
    const bf16_t* PZ; const float* bias;
    const float* xin_lat; const float* xin_ctx; float* xout_lat; float* xout_ctx; const float* gate; int chunk; float alpha;
    DI void operator()(const f32x4 (&acc)[2][2][4][2], const Unit& u, int wr, int wc, int fr, int fq) const {
        if constexpr (MODE == EP_PLAIN || MODE == EP_ROPE || MODE == EP_S5IN) {
            const int colt = u.pn * 256;
            const int t9 = u.pm % 9;
            const bool dorope = (MODE == EP_ROPE) && (colt < 2560) && (t9 != 0);
            const bool scat = (MODE == EP_S5IN) && (colt < 2048);
#pragma unroll
            for (int ai = 0; ai < 2; ++ai)
#pragma unroll
                for (int m = 0; m < 4; ++m) {
                    const int rl = u.pm * 256 + ai * 128 + wr * 64 + m * 16 + fr;
                    const int t = (t9 - 1) * 256 + ai * 128 + wr * 64 + m * 16 + fr;
#pragma unroll
                    for (int bj = 0; bj < 2; ++bj) {
                        f32x4 v0 = acc[ai][bj][m][0], v1 = acc[ai][bj][m][1];
                        const int c0 = colt + bj * 128 + wc * 32 + 8 * fq;
                        if (MODE == EP_ROPE && colt < 2048) { v0 = v0 * 0.12751743082459868f; v1 = v1 * 0.12751743082459868f; }
                        if (dorope) {
                            const int pos = (wc >> 1) ? (t & 63) : (t >> 6);
                            const int i0 = 16 * (wc & 1) + 4 * fq;
                            const f32x4 cs0 = *(const f32x4*)(rope + (pos * 32 + i0) * 2), cs1 = *(const f32x4*)(rope + (pos * 32 + i0) * 2 + 4);
                            f32x4 w0, w1;
                            w0[0] = v0[0] * cs0[0] - v0[1] * cs0[1]; w0[1] = v0[1] * cs0[0] + v0[0] * cs0[1];
                            w0[2] = v0[2] * cs0[2] - v0[3] * cs0[3]; w0[3] = v0[3] * cs0[2] + v0[2] * cs0[3];
                            w1[0] = v1[0] * cs1[0] - v1[1] * cs1[1]; w1[1] = v1[1] * cs1[0] + v1[0] * cs1[1];
                            w1[2] = v1[2] * cs1[2] - v1[3] * cs1[3]; w1[3] = v1[3] * cs1[2] + v1[2] * cs1[3];
                            v0 = w0; v1 = w1;
                        }
                        u32x4 w; w.x = pk2(v0[0], v0[1]); w.y = pk2(v0[2], v0[3]); w.z = pk2(v1[0], v1[1]); w.w = pk2(v1[2], v1[3]);
                        if (scat) {
                            const int gI = c0 >> 4, n0 = c0 & 15, bl = rl / TPB, loc = rl - bl * TPB, cc = loc >> 4, tau = loc & 15;
                            *(u32x4*)(UH + ((size_t)gI * 1280 + bl * 144 + cc) * 512 + tau * 16 + n0) = w;
                        } else {
                            *(u32x4*)(O + (size_t)u.z * zsC + (size_t)rl * ldc + c0) = w;
                        }
                    }
                }
        } else if constexpr (MODE == EP_F32) {
            float* base = C32 + (size_t)u.z * zsC;
#pragma unroll
            for (int ai = 0; ai < 2; ++ai)
#pragma unroll
                for (int m = 0; m < 4; ++m) {
                    const int rl = u.pm * 256 + ai * 128 + wr * 64 + m * 16 + fr;
#pragma unroll
                    for (int bj = 0; bj < 2; ++bj)
#pragma unroll
                        for (int n = 0; n < 2; ++n) *(f32x4*)(base + (size_t)rl * ldc + u.pn * 256 + bj * 128 + wc * 32 + n * 16 + 4 * fq) = acc[ai][bj][m][n];
                }
        } else if constexpr (MODE == EP_S5OUT) {
#pragma unroll
            for (int ai = 0; ai < 2; ++ai)
#pragma unroll
                for (int m = 0; m < 4; ++m) {
                    const int rl = u.pm * 256 + ai * 128 + wr * 64 + m * 16 + fr;
                    if (rl < NB * 144) {
                        const int bl = rl / 144, cc = rl - bl * 144;
#pragma unroll
                        for (int bj = 0; bj < 2; ++bj) {
                            const f32x4 v0 = acc[ai][bj][m][0], v1 = acc[ai][bj][m][1];
                            const int c0 = bj * 128 + wc * 32 + 8 * fq, tau = c0 >> 4, n0 = c0 & 15;
                            u32x4 w; w.x = pk2(gelu_tanh(v0[0]), gelu_tanh(v0[1])); w.y = pk2(gelu_tanh(v0[2]), gelu_tanh(v0[3]));
                            w.z = pk2(gelu_tanh(v1[0]), gelu_tanh(v1[1])); w.w = pk2(gelu_tanh(v1[2]), gelu_tanh(v1[3]));
                            *(u32x4*)(O + ((size_t)bl * TPB + cc * 16 + tau) * 4096 + u.z * 16 + n0) = w;
                        }
                    }
                }
        } else if constexpr (MODE == EP_GLU) {
#pragma unroll
            for (int ai = 0; ai < 2; ++ai)
#pragma unroll
                for (int m = 0; m < 4; ++m) {
                    const int rl = u.pm * 256 + ai * 128 + wr * 64 + m * 16 + fr;
#pragma unroll
                    for (int bj = 0; bj < 2; ++bj) {
                        const f32x4 v0 = acc[ai][bj][m][0], v1 = acc[ai][bj][m][1];
                        const int c0 = u.pn * 256 + bj * 128 + wc * 32 + 8 * fq;
                        const u32x4 g8 = *(const u32x4*)(PZ + (size_t)rl * 4096 + c0), z8 = *(const u32x4*)(PZ + (size_t)rl * 4096 + 2048 + c0);
                        const f32x4 b0 = *(const f32x4*)(bias + c0), b1 = *(const f32x4*)(bias + c0 + 4);
                        float o[8];
                        o[0] = glu_gate(bflo(g8.x), v0[0] + b0[0], bflo(z8.x)); o[1] = glu_gate(bfhi(g8.x), v0[1] + b0[1], bfhi(z8.x));
                        o[2] = glu_gate(bflo(g8.y), v0[2] + b0[2], bflo(z8.y)); o[3] = glu_gate(bfhi(g8.y), v0[3] + b0[3], bfhi(z8.y));
                        o[4] = glu_gate(bflo(g8.z), v1[0] + b1[0], bflo(z8.z)); o[5] = glu_gate(bfhi(g8.z), v1[1] + b1[1], bfhi(z8.z));
                        o[6] = glu_gate(bflo(g8.w), v1[2] + b1[2], bflo(z8.w)); o[7] = glu_gate(bfhi(g8.w), v1[3] + b1[3], bfhi(z8.w));
                        u32x4 w; w.x = pk2(o[0], o[1]); w.y = pk2(o[2], o[3]); w.z = pk2(o[4], o[5]); w.w = pk2(o[6], o[7]);
                        *(u32x4*)(O + (size_t)rl * ldc + c0) = w;
                    }
                }
        } else {
            const int bg = chunk + u.pm / 9, t9 = u.pm % 9;
            const float* xi; float* xo; const float* gt;
            if (t9 == 0) { xi = xin_ctx + (size_t)bg * 256 * D; xo = xout_ctx + (size_t)bg * 256 * D; gt = gate + 32 * 3072; }
            else { xi = xin_lat + ((size_t)bg * 2048 + (t9 - 1) * 256) * D; xo = xout_lat + ((size_t)bg * 2048 + (t9 - 1) * 256) * D; gt = gate + bg * 3072; }
#pragma unroll
            for (int ai = 0; ai < 2; ++ai)
#pragma unroll
                for (int m = 0; m < 4; ++m) {
                    const int rr = ai * 128 + wr * 64 + m * 16 + fr;
#pragma unroll
                    for (int bj = 0; bj < 2; ++bj)
#pragma unroll
                        for (int n = 0; n < 2; ++n) {
                            const int c = u.pn * 256 + bj * 128 + wc * 32 + n * 16 + 4 * fq;
                            const f32x4 xv = *(const f32x4*)(xi + (size_t)rr * D + c), gv = *(const f32x4*)(gt + c);
                            *(f32x4*)(xo + (size_t)rr * D + c) = xv * alpha + gv * acc[ai][bj][m][n];
                        }
                }
        }
    }
};

DI int qk_perm_row(int n) { const int head = n >> 7, d = n & 127, grp = d >> 6, j = d & 63, i = j & 31, part = j >> 5; return head * 128 + grp * 64 + 2 * i + part; }
DI void transpose_item(const float* W, int K, int N, bf16_t* WT, int permlim, LAS float* scr, int item, int lane) {
    const int nblk = N / 32, kb = item / nblk, nb = item % nblk, k0 = 64 * kb, n0 = 32 * nb;
#pragma unroll 8
    for (int i = 0; i < 32; ++i) { const int kk = 2 * i + (lane >> 5); scr[kk * 33 + (lane & 31)] = W[(size_t)(k0 + kk) * N + n0 + (lane & 31)]; }
    asm volatile("s_waitcnt lgkmcnt(0)" ::: "memory");
    const int c = lane & 7;
#pragma unroll
    for (int j = 0; j < 4; ++j) { const int n = (lane >> 3) + 8 * j; const LAS float* s = scr + (8 * c) * 33 + n;
        u32x4 o; o.x = pk2(s[0 * 33], s[1 * 33]); o.y = pk2(s[2 * 33], s[3 * 33]); o.z = pk2(s[4 * 33], s[5 * 33]); o.w = pk2(s[6 * 33], s[7 * 33]);
        const int ng = n0 + n, row = (ng < permlim) ? qk_perm_row(ng) : ng;
        *(u32x4*)(WT + (size_t)row * K + k0 + 8 * c) = o; }
    asm volatile("s_waitcnt lgkmcnt(0)" ::: "memory");
}

DI void phase_prologue(PRef P, LAS unsigned char* lds) {
    const int tid = opaque_tid(), lane = tid & 63, wave = tid >> 6, G = gridDim.x;
    {
        LAS float* scr = (LAS float*)(lds + wave * 8448);
        const int gw = blockIdx.x * 8 + wave, NGW = G * 8;
        constexpr int I_ATT = 16 * 160, I_S5 = 16 * 128, I_HG = 16 * 320, I_OUT = 32 * 32, I_GLU = 32 * 64;
        constexpr int NIT = 2 * I_ATT + I_S5 + I_HG + 4 * I_OUT + I_GLU;
        for (int it = gw; it < NIT; it += NGW) {
            int r = it;
            if (r < 2 * I_ATT) { const int j = r / I_ATT; transpose_item(P.in[IN_ATTW] + (size_t)j * 1024 * 5120, 1024, 5120, (bf16_t*)(P.ws + OFF_WT_ATT) + (size_t)j * 5120 * 1024, 2560, scr, r % I_ATT, lane); continue; }
            r -= 2 * I_ATT;
            if (r < I_S5) { transpose_item(P.in[IN_S5W], 1024, 4096, (bf16_t*)(P.ws + OFF_WT_S5), 0, scr, r, lane); continue; }
            r -= I_S5;
            if (r < I_HG) { transpose_item(P.in[IN_HGW], 1024, 10240, (bf16_t*)(P.ws + OFF_WT_HG), 0, scr, r, lane); continue; }
            r -= I_HG;
            if (r < 4 * I_OUT) { const int j = r / I_OUT; transpose_item(P.in[IN_WOUT] + (size_t)j * 2048 * 1024, 2048, 1024, (bf16_t*)(P.ws + OFF_WT_OUT) + (size_t)j * 1024 * 2048, 0, scr, r % I_OUT, lane); continue; }
            r -= 4 * I_OUT;
            transpose_item(P.in[IN_GLUW], 2048, 2048, (bf16_t*)(P.ws + OFF_WT_GLU), 0, scr, r, lane);
        }
    }
    {
        float* rope = (float*)(P.ws + OFF_ROPE);
        for (int idx = blockIdx.x * 512 + tid; idx < 2048; idx += G * 512) {
            const int pos = idx >> 5, i = idx & 31;
            const float invf = exp2f(-(float)i * (13.287712379549449f / 32.0f));
            const float ang = (float)pos * invf;
            rope[idx * 2] = cosf(ang); rope[idx * 2 + 1] = sinf(ang);
        }
    }
    __syncthreads();
    {
        LAS float* SC = (LAS float*)lds;
        float* mods = (float*)(P.ws + OFF_MODS);
        bool filled = false;
        for (int it = blockIdx.x; it < 192; it += G) {
            if (!filled) {
                for (int i = tid; i < 33 * 1024; i += 512) { const int bi = i >> 10, k = i & 1023; const float cv = (bi < 32) ? P.in[IN_C][bi * 1024 + k] : P.in[IN_CCTX][k]; SC[i] = siluf_(cv); }
                filled = true;
            }
            __syncthreads();
            const int layer = it / 48, col = (it % 48) * 64 + lane;
            const float* W = P.in[IN_ADAW] + (size_t)layer * 1024 * 3072 + col;
            float a[33];
#pragma unroll
            for (int b = 0; b < 33; ++b) a[b] = 0.f;
            for (int k = wave * 128; k < wave * 128 + 128; ++k) {
                const float w = W[(size_t)k * 3072];
#pragma unroll
                for (int b = 0; b < 33; ++b) a[b] += SC[b * 1024 + k] * w;
            }
            __syncthreads();
            LAS float* RED = (LAS float*)lds;
#pragma unroll
            for (int b = 0; b < 33; ++b) RED[(wave * 33 + b) * 64 + lane] = a[b];
            __syncthreads();
            for (int o = tid; o < 33 * 64; o += 512) {
                const int b = o >> 6, l = o & 63; float s = 0.f;
#pragma unroll
                for (int w = 0; w < 8; ++w) s += RED[(w * 33 + b) * 64 + l];
                const int cc = (it % 48) * 64 + l;
                mods[((size_t)layer * 33 + b) * 3072 + cc] = s + P.in[IN_ADAB][layer * 3072 + cc];
            }
            __syncthreads();
            filled = false;
        }
    }
    __syncthreads();
    {
        LAS f32x2* APOW = (LAS f32x2*)lds;
        LAS f32x2* BBAR = (LAS f32x2*)(lds + 17408);
        LAS f32x2* CM = (LAS f32x2*)(lds + 17408 + 16384);
        LAS float* KT = (LAS float*)(lds + 17408 + 32768);
        bf16_t* BT1 = (bf16_t*)(P.ws + OFF_BT1); bf16_t* BT3 = (bf16_t*)(P.ws + OFF_BT3);
        for (int g = G - 1 - blockIdx.x; g < 128; g += G) {
            if (g < 0) break;
            for (int i = tid; i < 2 * 17 * 64; i += 512) {
                const int p = i & 63, k = (i >> 6) % 17, dir = i / (17 * 64);
                const float lre = P.in[IN_LRE][(dir * 128 + g) * 64 + p], lim = P.in[IN_LIM][(dir * 128 + g) * 64 + p], dt = expf(P.in[IN_LSTEP][dir * 128 + g]);
                const float mag = expf((float)k * lre * dt), ang = (float)k * lim * dt;
                APOW[i] = (f32x2){mag * cosf(ang), mag * sinf(ang)};
            }
            for (int i = tid; i < 2048; i += 512) {
                const int n = i & 15, p = (i >> 4) & 63, dir = i >> 10;
                const float lre = P.in[IN_LRE][(dir * 128 + g) * 64 + p], lim = P.in[IN_LIM][(dir * 128 + g) * 64 + p], dt = expf(P.in[IN_LSTEP][dir * 128 + g]);
                const float mag = expf(lre * dt), ang = lim * dt;
                const float nr = mag * cosf(ang) - 1.0f, ni = mag * sinf(ang), den = 1.0f / (lre * lre + lim * lim);
                const float cr = (nr * lre + ni * lim) * den, ci = (ni * lre - nr * lim) * den;
                const size_t bi = (((size_t)dir * 128 + g) * 64 + p) * 16 + n;
                const float br = P.in[IN_BRE][bi], bim = P.in[IN_BIM][bi];
                BBAR[i] = (f32x2){cr * br - ci * bim, cr * bim + ci * br};
                const int p2 = i & 63, n2 = (i >> 6) & 15;
                const size_t cidx = (((size_t)dir * 128 + g) * 16 + n2) * 64 + p2;
                CM[i] = (f32x2){P.in[IN_CRE][cidx], P.in[IN_CIM][cidx]};
            }
            __syncthreads();
            for (int i = tid; i < 8192; i += 512) {
                const int ni = i & 15, no = (i >> 4) & 15, k = (i >> 8) & 15, dir = i >> 12;
                float s = 0.f;
                for (int p = 0; p < 64; ++p) {
                    const f32x2 a = APOW[(dir * 17 + k) * 64 + p], b = BBAR[(dir * 64 + p) * 16 + ni], c = CM[(dir * 16 + no) * 64 + p];
                    const float wr_ = a.x * b.x - a.y * b.y, wi_ = a.x * b.y + a.y * b.x;
                    s += c.x * wr_ - c.y * wi_;
                }
                KT[i] = s;
            }
            __syncthreads();
            for (int v = tid; v < 256 * 32; v += 512) {
                const int nidx = v >> 5, kk0 = (v & 31) * 8, dir = nidx >> 7, p = (nidx >> 1) & 63, ri = nidx & 1, tau = kk0 >> 4, n0 = kk0 & 15;
                const int e = dir ? tau : 15 - tau;
                const f32x2 a = APOW[(dir * 17 + e) * 64 + p];
                float o[8];
#pragma unroll
                for (int j = 0; j < 8; ++j) { const f32x2 b = BBAR[(dir * 64 + p) * 16 + n0 + j]; o[j] = ri ? (a.x * b.y + a.y * b.x) : (a.x * b.x - a.y * b.y); }
                u32x4 w; w.x = pk2(o[0], o[1]); w.y = pk2(o[2], o[3]); w.z = pk2(o[4], o[5]); w.w = pk2(o[6], o[7]);
                *(u32x4*)(BT1 + ((size_t)g * 256 + nidx) * 256 + kk0) = w;
            }
            for (int v = tid; v < 256 * 64; v += 512) {
                const int nidx = v >> 6, kk0 = (v & 63) * 8, tau = nidx >> 4, no = nidx & 15;
                float o[8];
                if (kk0 < 256) {
                    const int s = kk0 >> 4, ni0 = kk0 & 15;
#pragma unroll
                    for (int j = 0; j < 8; ++j) {
                        float x = 0.f;
                        if (tau >= s) x += KT[((0 * 16 + (tau - s)) * 16 + no) * 16 + ni0 + j];
                        if (s >= tau) x += KT[((1 * 16 + (s - tau)) * 16 + no) * 16 + ni0 + j];
                        if (s == tau && ni0 + j == no) x += P.in[IN_S5D][g * 16 + no];
                        o[j] = x;
                    }
                } else {
                    const int q = kk0 - 256, dir = q >> 7, p0 = (q & 127) >> 1;
                    const int e = dir ? 16 - tau : tau + 1;
#pragma unroll
                    for (int j = 0; j < 4; ++j) {
                        const f32x2 a = APOW[(dir * 17 + e) * 64 + p0 + j], c = CM[(dir * 16 + no) * 64 + p0 + j];
                        o[2 * j] = c.x * a.x - c.y * a.y; o[2 * j + 1] = -(c.x * a.y + c.y * a.x);
                    }
                }
                u32x4 w; w.x = pk2(o[0], o[1]); w.y = pk2(o[2], o[3]); w.z = pk2(o[4], o[5]); w.w = pk2(o[6], o[7]);
                *(u32x4*)(BT3 + ((size_t)g * 256 + nidx) * 512 + kk0) = w;
            }
            __syncthreads();
        }
    }
}

DI size_t xrow_off(int b0, int rl, bool& isctx, int& bg) { const int bl = rl / TPB, loc = rl - bl * TPB; bg = b0 + bl; isctx = loc < 256; return isctx ? ((size_t)bg * 256 + loc) * D : ((size_t)bg * 2048 + (loc - 256)) * D; }

DI void phase_modulate0(PRef P) {
    const float* mods = (const float*)(P.ws + OFF_MODS);
    bf16_t* H = (bf16_t*)(P.ws + OFF_H);
    const size_t GT = (size_t)gridDim.x * 512, NIT = (size_t)73728 * 128;
    for (size_t i0 = (size_t)blockIdx.x * 512 + opaque_tid(); i0 < NIT; i0 += 4 * GT) {
        f32x4 x0[4], x1[4]; const float* mp[4];
#pragma unroll
        for (int k = 0; k < 4; ++k) {
            const size_t i = i0 + k * GT;
            if (i < NIT) {
                const int row = (int)(i >> 7), c = (int)(i & 127) * 8;
                bool isctx; int bg; const size_t off = xrow_off(0, row, isctx, bg);
                const float* xp = (isctx ? P.in[IN_CTX] : P.in[IN_X]) + off + c;
                mp[k] = mods + (size_t)(isctx ? 32 : bg) * 3072 + c;
                x0[k] = *(const f32x4*)xp; x1[k] = *(const f32x4*)(xp + 4);
            } else { mp[k] = mods; x0[k] = (f32x4){0.f, 0.f, 0.f, 0.f}; x1[k] = x0[k]; }
        }
#pragma unroll
        for (int k = 0; k < 4; ++k) {
            const size_t i = i0 + k * GT;
            if (i < NIT) {
                const int row = (int)(i >> 7), c = (int)(i & 127) * 8;
                const f32x4 sh0 = *(const f32x4*)mp[k], sh1 = *(const f32x4*)(mp[k] + 4), sc0 = *(const f32x4*)(mp[k] + 1024), sc1 = *(const f32x4*)(mp[k] + 1028);
                const f32x4 h0 = x0[k] * (sc0 + 1.0f) + sh0, h1 = x1[k] * (sc1 + 1.0f) + sh1;
                u32x4 w; w.x = pk2(h0[0], h0[1]); w.y = pk2(h0[2], h0[3]); w.z = pk2(h1[0], h1[1]); w.w = pk2(h1[2], h1[3]);
                *(u32x4*)(H + (size_t)row * D + c) = w;
            }
        }
    }
}

DI void phase_ln(PRef P, int layer, int b0, int nb, int wg0 = 0, int nwg = 0) {
    const int NROWS = nb * TPB;
    const bool last = layer == 3;
    const float* mods = (const float*)(P.ws + OFF_MODS) + (size_t)(layer + 1) * 33 * 3072;
    const float* lg = P.in[IN_LNG] + layer * D; const float* lb = P.in[IN_LNB] + layer * D;
    bf16_t* H = (bf16_t*)(P.ws + OFF_H);
    float* xctx = (float*)(P.ws + OFF_XCTX);
    if (nwg == 0) nwg = gridDim.x;
    if ((int)blockIdx.x < wg0 || (int)blockIdx.x >= wg0 + nwg) return;
    const int tid_ = opaque_tid(), lane = tid_ & 63, gw = ((int)blockIdx.x - wg0) * 8 + (tid_ >> 6), NGW = nwg * 8;
    for (int rl0 = gw; rl0 < NROWS; rl0 += 3 * NGW) {
        f32x4 v[3][4]; float* xp[3]; const float* mp[3]; bool ok[3]; int rls[3];
#pragma unroll
        for (int k = 0; k < 3; ++k) {
            const int rl = rl0 + k * NGW; rls[k] = rl;
            bool isctx = false; int bg = 0; size_t off = 0;
            ok[k] = rl < NROWS;
            if (ok[k]) off = xrow_off(b0, rl, isctx, bg);
            if (last && isctx) ok[k] = false;
            xp[k] = (isctx ? xctx : P.out) + off;
            mp[k] = mods + (size_t)(isctx ? 32 : bg) * 3072;
            if (ok[k]) {
#pragma unroll
                for (int j = 0; j < 4; ++j) v[k][j] = *(const f32x4*)(xp[k] + (lane + 64 * j) * 4);
            } else {
#pragma unroll
                for (int j = 0; j < 4; ++j) v[k][j] = (f32x4){0.f, 0.f, 0.f, 0.f};
            }
        }
        float s[3], s2[3];
#pragma unroll
        for (int k = 0; k < 3; ++k) { s[k] = 0.f;
#pragma unroll
            for (int j = 0; j < 4; ++j) s[k] += (v[k][j][0] + v[k][j][1]) + (v[k][j][2] + v[k][j][3]); }
#pragma unroll
        for (int o = 1; o < 64; o <<= 1)
#pragma unroll
            for (int k = 0; k < 3; ++k) s[k] += __shfl_xor(s[k], o);
#pragma unroll
        for (int k = 0; k < 3; ++k) { const float mean = s[k] * (1.0f / D); s2[k] = 0.f;
#pragma unroll
            for (int j = 0; j < 4; ++j) { v[k][j] = v[k][j] - mean; s2[k] += (v[k][j][0] * v[k][j][0] + v[k][j][1] * v[k][j][1]) + (v[k][j][2] * v[k][j][2] + v[k][j][3] * v[k][j][3]); } }
#pragma unroll
        for (int o = 1; o < 64; o <<= 1)
#pragma unroll
            for (int k = 0; k < 3; ++k) s2[k] += __shfl_xor(s2[k], o);
#pragma unroll
        for (int k = 0; k < 3; ++k) {
            if (!ok[k]) continue;
            const float rstd = rsqrtf(s2[k] * (1.0f / D) + 1e-5f);
#pragma unroll
            for (int j = 0; j < 4; ++j) {
                const int c = (lane + 64 * j) * 4;
                const f32x4 y = v[k][j] * rstd * *(const f32x4*)(lg + c) + *(const f32x4*)(lb + c);
                *(f32x4*)(xp[k] + c) = y;
                if (!last) {
                    const f32x4 h = y * (*(const f32x4*)(mp[k] + 1024 + c) + 1.0f) + *(const f32x4*)(mp[k] + c);
                    u32x2 w; w.x = pk2(h[0], h[1]); w.y = pk2(h[2], h[3]);
                    *(u32x2*)(H + ((size_t)b0 * TPB + rls[k]) * D + c) = w;
                }
            }
        }
    }
}

DI bool ln_row_load(PRef P, int b0, int nrows, int rl, int lane, f32x4 (&v)[4]) {
    if (rl >= nrows) return false;
    bool isctx; int bg; const size_t off = xrow_off(b0, rl, isctx, bg);
    const float* xp = (isctx ? (const float*)(P.ws + OFF_XCTX) : (const float*)P.out) + off;
#pragma unroll
    for (int j = 0; j < 4; ++j) v[j] = *(const f32x4*)(xp + (lane + 64 * j) * 4);
    return true;
}
DI void ln_row_finish(PRef P, int layer, int b0, int rl, int lane, f32x4 (&v)[4]) {
    bool isctx; int bg; const size_t off = xrow_off(b0, rl, isctx, bg);
    float* xp = (isctx ? (float*)(P.ws + OFF_XCTX) : P.out) + off;
    const float* mp = (const float*)(P.ws + OFF_MODS) + (size_t)(layer + 1) * 33 * 3072 + (size_t)(isctx ? 32 : bg) * 3072;
    const float* lg = P.in[IN_LNG] + layer * D; const float* lb = P.in[IN_LNB] + layer * D;
    bf16_t* H = (bf16_t*)(P.ws + OFF_H);
    float s = 0.f;
#pragma unroll
    for (int j = 0; j < 4; ++j) s += (v[j][0] + v[j][1]) + (v[j][2] + v[j][3]);
#pragma unroll
    for (int o = 1; o < 64; o <<= 1) s += __shfl_xor(s, o);
    const float mean = s * (1.0f / D); float s2 = 0.f;
#pragma unroll
    for (int j = 0; j < 4; ++j) { v[j] = v[j] - mean; s2 += (v[j][0] * v[j][0] + v[j][1] * v[j][1]) + (v[j][2] * v[j][2] + v[j][3] * v[j][3]); }
#pragma unroll
    for (int o = 1; o < 64; o <<= 1) s2 += __shfl_xor(s2, o);
    const float rstd = rsqrtf(s2 * (1.0f / D) + 1e-5f);
#pragma unroll
    for (int j = 0; j < 4; ++j) {
        const int c = (lane + 64 * j) * 4;
        const f32x4 y = v[j] * rstd * *(const f32x4*)(lg + c) + *(const f32x4*)(lb + c);
        *(f32x4*)(xp + c) = y;
        const f32x4 h = y * (*(const f32x4*)(mp + 1024 + c) + 1.0f) + *(const f32x4*)(mp + c);
        u32x2 w; w.x = pk2(h[0], h[1]); w.y = pk2(h[2], h[3]);
        *(u32x2*)(H + ((size_t)b0 * TPB + rl) * D + c) = w;
    }
}

DI void phase_attn(PRef P, LAS unsigned char* lds, int aj, bool last, int nb) {
    const bf16_t* PZ = (const bf16_t*)(P.ws + OFF_PZ);
    bf16_t* AO = (bf16_t*)(P.ws + OFF_AOUT);
    LAS bf16_t* Ks0 = (LAS bf16_t*)lds;
    LAS bf16_t* Vt0 = (LAS bf16_t*)(lds + 34816);
    const int tid = opaque_tid(), w = tid >> 6, lane = tid & 63, r = lane & 31, h = lane >> 5;
    const int nlat = nb * 128, nitems = last ? nlat : nlat + nb * 16;
    u32x4 kreg[2], vreg[2];
    bool have_pref = false;
    for (int it = blockIdx.x; it < nitems; it += gridDim.x) {
        int bl, hk, qb; bool isctx;
        if (it < nlat) { const int ip = (it & 7) * (nlat >> 3) + (it >> 3); bl = ip >> 7; hk = (ip >> 5) & 3; qb = ip & 31; isctx = false; }
        else { const int x = it - nlat; bl = x >> 4; hk = (x >> 2) & 3; qb = x & 3; isctx = true; }
        const int rowb = bl * TPB, s0 = qb * 64;
        const int head = hk * 4 + (w >> 1), qoff = 32 * (w & 1);
        const int qrow = rowb + (isctx ? 0 : 256) + s0 + qoff + r;
        bf16x8 qf[8];
        {
            LAS bf16_t* QL = (LAS bf16_t*)(lds + 75776) + w * (32 * 136);
            const int qrow0 = qrow - r;
            u32x4 t[8];
#pragma unroll
            for (int k = 0; k < 8; ++k) { const int p = lane + 64 * k, row = p >> 4, dg = p & 15; t[k] = *(const u32x4*)(PZ + (size_t)(qrow0 + row) * 5120 + head * 128 + dg * 8); }
#pragma unroll
            for (int k = 0; k < 8; ++k) { const int p = lane + 64 * k, row = p >> 4, dg = p & 15; *(LAS u32x4*)(QL + row * 136 + dg * 8) = t[k]; }
            asm volatile("s_waitcnt lgkmcnt(0)" ::: "memory");
#pragma unroll
            for (int s = 0; s < 8; ++s) qf[s] = *(const LAS bf16x8*)(QL + r * 136 + 16 * s + 8 * h);
        }
        int t_lo = 0, nw = 0;
        if (!isctx) { t_lo = s0 >= 128 ? 0 : (s0 >= 64 ? 1 : 2); int t_hi = (2176 - s0) / 64; if (t_hi > 5) t_hi = 5; nw = t_hi - t_lo; }
        const int ntiles = nw + 4;
        float m = P.in[IN_SINK][aj * 16 + head] * 1.4426950408889634f, l = h ? 0.0f : 1.0f;
        f32x16 oacc[4];
#pragma unroll
        for (int d = 0; d < 4; ++d)
#pragma unroll
            for (int i = 0; i < 16; ++i) oacc[d][i] = 0.f;
        auto tile_row0 = [&](int n) -> int { return n < nw ? rowb + 256 + s0 - 128 + 64 * (t_lo + n) : rowb + 64 * (n - nw); };
        auto prefetch_at = [&](int kr0, int hkx) {
#pragma unroll
            for (int i = 0; i < 2; ++i) { const int p = tid + 512 * i, key = p >> 4, dg = p & 15; kreg[i] = *(const u32x4*)(PZ + (size_t)(kr0 + key) * 5120 + 2048 + hkx * 128 + dg * 8); }
#pragma unroll
            for (int i = 0; i < 2; ++i) { const int p = tid + 512 * i, key = p >> 4, dg = p & 15; vreg[i] = *(const u32x4*)(PZ + (size_t)(kr0 + key) * 5120 + 2560 + hkx * 128 + dg * 8); }
        };
        auto prefetch = [&](int n) { prefetch_at(tile_row0(n), hk); };
        auto stage = [&](int bsel) {
            LAS bf16_t* Kd = Ks0 + bsel * 8704; LAS bf16_t* Vd = Vt0 + bsel * 10240;
#pragma unroll
            for (int i = 0; i < 2; ++i) { const int p = tid + 512 * i, key = p >> 4, dg = p & 15; *(LAS u32x4*)(Kd + key * 136 + dg * 8) = kreg[i]; *(LAS u32x4*)(Vd + key * 160 + dg * 8) = vreg[i]; }
        };
        if (!have_pref) prefetch(0);
        stage(0);
        if (ntiles > 1) prefetch(1);
        __syncthreads();
        for (int n = 0; n < ntiles; ++n) {
            const LAS bf16_t* Ks = Ks0 + (n & 1) * 8704; const LAS bf16_t* Vt = Vt0 + (n & 1) * 10240;
            f32x16 sacc[2];
            {
#pragma unroll
                for (int kt = 0; kt < 2; ++kt)
#pragma unroll
                    for (int i = 0; i < 16; ++i) sacc[kt][i] = -m;
#pragma unroll
                for (int sb = 0; sb < 2; ++sb) {
                    bf16x8 kf[2][4];
#pragma unroll
                    for (int kt = 0; kt < 2; ++kt)
#pragma unroll
                        for (int s = 0; s < 4; ++s) kf[kt][s] = *(const LAS bf16x8*)(Ks + (32 * kt + r) * 136 + 16 * (4 * sb + s) + 8 * h);
                    __builtin_amdgcn_sched_barrier(0);
#pragma unroll
                    for (int s = 0; s < 4; ++s) { sacc[0] = MFMA32(kf[0][s], qf[4 * sb + s], sacc[0]); sacc[1] = MFMA32(kf[1][s], qf[4 * sb + s], sacc[1]); }
                }
            }
            const int wt = t_lo + n;
            const bool edge = (n < nw) && (wt == 0 || wt == 4);
#pragma unroll
            for (int kt = 0; kt < 2; ++kt) {
                if (edge) {
                    const int kpos0 = s0 - 128 + 64 * wt + 32 * kt, qpos = s0 + qoff + r;
#pragma unroll
                    for (int i = 0; i < 16; ++i) { const int dlt = qpos - (kpos0 + crow(i, h)); if (dlt > 128 || dlt < -128) sacc[kt][i] = -1.0e30f; }
                }
                float mx = -3.0e38f;
#pragma unroll
                for (int i = 0; i < 16; ++i) mx = fmaxf(mx, sacc[kt][i]);
                mx = xhalf_max(mx);
                if (__builtin_amdgcn_ballot_w64(mx > 8.0f) != 0ull) {
                    const float dm = fmaxf(mx, 0.0f), alpha = __builtin_amdgcn_exp2f(-dm);
                    l *= alpha; m += dm;
#pragma unroll
                    for (int d = 0; d < 4; ++d)
#pragma unroll
                        for (int i = 0; i < 16; ++i) oacc[d][i] *= alpha;
#pragma unroll
                    for (int i = 0; i < 16; ++i) sacc[kt][i] -= dm;
                    if (kt == 0) {
#pragma unroll
                        for (int i = 0; i < 16; ++i) sacc[1][i] -= dm;
                    }
                }
#pragma unroll
                for (int i = 0; i < 16; ++i) { const float pv = __builtin_amdgcn_exp2f(sacc[kt][i]); sacc[kt][i] = pv; l += pv; }
#pragma unroll
                for (int s = 0; s < 2; ++s) {
                    u32x4 pw; pw.x = pk2(sacc[kt][8 * s], sacc[kt][8 * s + 1]); pw.y = pk2(sacc[kt][8 * s + 2], sacc[kt][8 * s + 3]);
                    pw.z = pk2(sacc[kt][8 * s + 4], sacc[kt][8 * s + 5]); pw.w = pk2(sacc[kt][8 * s + 6], sacc[kt][8 * s + 7]);
                    const bf16x8 pb = __builtin_bit_cast(bf16x8, pw);
#pragma unroll
                    for (int d = 0; d < 4; ++d) {
                        const LAS bf16_t* vb = Vt + (32 * kt + 16 * s + 4 * h + ((lane & 15) >> 2)) * 160 + 32 * d + 16 * ((lane >> 4) & 1) + 4 * (lane & 3);
                        const s16x4 lo = LDS_TR16(vb), hi = LDS_TR16(vb + 8 * 160);
                        const bf16x8 av = __builtin_shufflevector(lo, hi, 0, 1, 2, 3, 4, 5, 6, 7);
                        oacc[d] = MFMA32(av, pb, oacc[d]);
                    }
                }
            }
            if (n + 1 < ntiles) { stage((n + 1) & 1); if (n + 2 < ntiles) prefetch(n + 2); }
            else {
                const int itn = it + gridDim.x; have_pref = itn < nitems;
                if (have_pref) {
                    int bl2, hk2, qb2; bool ctx2;
                    if (itn < nlat) { const int ip = (itn & 7) * (nlat >> 3) + (itn >> 3); bl2 = ip >> 7; hk2 = (ip >> 5) & 3; qb2 = ip & 31; ctx2 = false; }
                    else { const int x = itn - nlat; bl2 = x >> 4; hk2 = (x >> 2) & 3; qb2 = x & 3; ctx2 = true; }
                    const int s2 = qb2 * 64, tl2 = ctx2 ? 0 : (s2 >= 128 ? 0 : (s2 >= 64 ? 1 : 2));
                    prefetch_at(ctx2 ? bl2 * TPB : bl2 * TPB + 256 + s2 - 128 + 64 * tl2, hk2);
                }
            }
            __syncthreads();
        }
        l = xhalf_sum(l);
        const float inv = 1.0f / l;
        {
            LAS bf16_t* OL = (LAS bf16_t*)lds + w * (32 * 136);
#pragma unroll
            for (int d = 0; d < 4; ++d)
#pragma unroll
                for (int gq = 0; gq < 4; ++gq) {
                    u32x2 o; o.x = pk2(oacc[d][4 * gq] * inv, oacc[d][4 * gq + 1] * inv); o.y = pk2(oacc[d][4 * gq + 2] * inv, oacc[d][4 * gq + 3] * inv);
                    *(LAS u32x2*)(OL + r * 136 + 32 * d + 8 * gq + 4 * h) = o;
                }
            asm volatile("s_waitcnt lgkmcnt(0)" ::: "memory");
            const int qrow0 = rowb + (isctx ? 0 : 256) + s0 + qoff;
#pragma unroll
            for (int hb = 0; hb < 2; ++hb) {
                u32x4 zz[4], ov[4];
#pragma unroll
                for (int k = 0; k < 4; ++k) { const int p = lane + 64 * (4 * hb + k), row = p >> 4, dg = p & 15;
                    zz[k] = *(const u32x4*)(PZ + (size_t)(qrow0 + row) * 5120 + 3072 + head * 128 + dg * 8);
                    ov[k] = *(const LAS u32x4*)(OL + row * 136 + dg * 8); }
#pragma unroll
                for (int k = 0; k < 4; ++k) { const int p = lane + 64 * (4 * hb + k), row = p >> 4, dg = p & 15;
                    u32x4 o;
                    o.x = pk2(bflo(ov[k].x) * siluf_(bflo(zz[k].x)), bfhi(ov[k].x) * siluf_(bfhi(zz[k].x)));
                    o.y = pk2(bflo(ov[k].y) * siluf_(bflo(zz[k].y)), bfhi(ov[k].y) * siluf_(bfhi(zz[k].y)));
                    o.z = pk2(bflo(ov[k].z) * siluf_(bflo(zz[k].z)), bfhi(ov[k].z) * siluf_(bfhi(zz[k].z)));
                    o.w = pk2(bflo(ov[k].w) * siluf_(bflo(zz[k].w)), bfhi(ov[k].w) * siluf_(bfhi(zz[k].w)));
                    *(u32x4*)(AO + (size_t)(qrow0 + row) * 2048 + head * 128 + dg * 8) = o; }
            }
        }
        __syncthreads();
    }
    __syncthreads();
}

DI void phase_s5scan(PRef P) {
    const bf16_t* HL = (const bf16_t*)(P.ws + OFF_HLOC);
    bf16_t* UH = (bf16_t*)(P.ws + OFF_UH);
    for (int idx = blockIdx.x * 512 + opaque_tid(); idx < 131072; idx += gridDim.x * 512) {
        const int p = idx & 63, dir = (idx >> 6) & 1, bl = (idx >> 7) & 7, g = idx >> 10;
        const float lre = P.in[IN_LRE][(dir * 128 + g) * 64 + p], lim = P.in[IN_LIM][(dir * 128 + g) * 64 + p], dt = expf(P.in[IN_LSTEP][dir * 128 + g]);
        const float mag = expf(16.0f * lre * dt), ang = 16.0f * lim * dt;
        const float ar = mag * cosf(ang), ai = mag * sinf(ang);
        float hr = 0.f, hi = 0.f;
        const size_t rb = (size_t)g * 1280 + bl * 144;
        for (int s0 = 0; s0 < 144; s0 += 16) {
            unsigned v[16]; int cs[16];
#pragma unroll
            for (int j = 0; j < 16; ++j) { const int st = s0 + j; cs[j] = dir ? (st < 16 ? 15 - st : 159 - st) : st; v[j] = *(const unsigned*)(HL + (rb + cs[j]) * 256 + dir * 128 + 2 * p); }
#pragma unroll
            for (int j = 0; j < 16; ++j) {
                *(unsigned*)(UH + (rb + cs[j]) * 512 + 256 + dir * 128 + 2 * p) = pk2(hr, hi);
                const float nr = ar * hr - ai * hi + bflo(v[j]), ni = ar * hi + ai * hr + bfhi(v[j]); hr = nr; hi = ni;
            }
        }
    }
}

DI void phase_hgrn(PRef P, LAS unsigned char* lds, int layer, int lnl, int lnb0, int lnnb) {
    bf16_t* PZ = (bf16_t*)(P.ws + OFF_PZ);
    LAS bf16_t* QS = (LAS bf16_t*)lds;
    LAS bf16_t* KS = (LAS bf16_t*)(lds + 17408);
    LAS bf16_t* VR = (LAS bf16_t*)(lds + 34816);
    LAS bf16_t* KDT = (LAS bf16_t*)(lds + 55296);
    LAS bf16_t* ST = (LAS bf16_t*)(lds + 73728);
    LAS float* TOT = (LAS float*)(lds + 109056);
    LAS float* EB = (LAS float*)(lds + 108544);
    const int tid = opaque_tid(), w = tid >> 6, lane = tid & 63, r = lane & 31, h = lane >> 5;
    const int seg = tid >> 6, c0 = (tid & 63) * 2;
    const int ln_gw = blockIdx.x * 8 + w, ln_ngw = gridDim.x * 8, ln_rows = lnnb * TPB; int ln_round = 0;
    for (int it = blockIdx.x; it < NB * 16 * 2; it += gridDim.x) {
        const int dir = it & 1, hd = (it >> 1) & 15, bl = it >> 5;
        const int rowb = bl * TPB;
        f32x2 lb2;
#pragma unroll
        for (int q = 0; q < 2; ++q) {
            const int e = hd * 128 + c0 + q; const float a0 = P.in[IN_HGLB][e], a1 = P.in[IN_HGLB][2048 + e], a2 = P.in[IN_HGLB][4096 + e], a3 = P.in[IN_HGLB][6144 + e];
            const float mxx = fmaxf(fmaxf(a0, a1), fmaxf(a2, a3)); const float e0 = __expf(a0 - mxx), e1 = __expf(a1 - mxx), e2 = __expf(a2 - mxx), e3 = __expf(a3 - mxx);
            const float ev[4] = {e0, e1, e2, e3}; float num = 0.f;
#pragma unroll
            for (int j = 1; j < 4; ++j) if (j <= layer) num += ev[j];
            lb2[q] = num / (e0 + e1 + e2 + e3);
        }
        const int fcol = 2048 + dir * 2048 + hd * 128;
        for (int i = tid; i < 128 * 136 / 2; i += 512) ((LAS unsigned*)ST)[i] = 0u;
        f32x16 sacc[2];
#pragma unroll
        for (int x = 0; x < 2; ++x)
#pragma unroll
            for (int i = 0; i < 16; ++i) sacc[x][i] = 0.f;
        auto grow = [&](int ci, int tau) -> int { const int q = ci * 64 + tau; return dir ? (ci < 4 ? rowb + 255 - q : rowb + 256 + 2047 - (q - 256)) : rowb + q; };
        u32x4 qreg[2], freg[2], vreg[2];
        auto prefetch = [&](int ci) {
#pragma unroll
            for (int i = 0; i < 2; ++i) { const int p = tid + 512 * i, row = p >> 4, dg = p & 15; const size_t ro = (size_t)grow(ci, row) * 10240;
                qreg[i] = *(const u32x4*)(PZ + ro + hd * 128 + dg * 8); freg[i] = *(const u32x4*)(PZ + ro + fcol + dg * 8); }
#pragma unroll
            for (int i = 0; i < 2; ++i) { const int p = tid + 512 * i, row = p >> 4, dg = p & 15; vreg[i] = *(const u32x4*)(PZ + (size_t)grow(ci, row) * 10240 + 6144 + hd * 128 + dg * 8); }
        };
        prefetch(0);
        for (int ci = 0; ci < 36; ++ci) {
            __syncthreads();
            f32x4 lnv[4]; int ln_rl = ln_round * ln_ngw + ln_gw; bool ln_do = false;
            if (lnl >= 0 && (ci & 3) == 0) { ln_do = ln_row_load(P, lnb0, ln_rows, ln_rl, lane, lnv); ++ln_round; }
            if (ci > 0) {
                const int ct = w >> 1;
#pragma unroll
                for (int x = 0; x < 2; ++x)
#pragma unroll
                    for (int gq = 0; gq < 4; ++gq) {
                        u32x2 o; o.x = pk2(sacc[x][4 * gq], sacc[x][4 * gq + 1]); o.y = pk2(sacc[x][4 * gq + 2], sacc[x][4 * gq + 3]);
                        *(LAS u32x2*)(ST + (32 * (2 * (w & 1) + x) + r) * 136 + 32 * ct + 8 * gq + 4 * h) = o;
                    }
            }
#pragma unroll
            for (int i = 0; i < 2; ++i) { const int p = tid + 512 * i, row = p >> 4, dg = p & 15; *(LAS u32x4*)(QS + row * 136 + dg * 8) = qreg[i]; *(LAS u32x4*)(KS + row * 136 + dg * 8) = freg[i]; }
#pragma unroll
            for (int i = 0; i < 2; ++i) { const int p = tid + 512 * i, row = p >> 4, dg = p & 15; *(LAS u32x4*)(VR + row * 160 + dg * 8) = vreg[i]; }
            __syncthreads();
            if (ci + 1 < 36) prefetch(ci + 1);
            f32x2 qv[8], kv[8], cum[8];
            {
                f32x2 run = {1.f, 1.f};
#pragma unroll
                for (int j = 0; j < 8; ++j) {
                    const int tau = seg * 8 + j;
                    const unsigned qq = *(const LAS unsigned*)(QS + tau * 136 + c0), ff = *(const LAS unsigned*)(KS + tau * 136 + c0);
                    qv[j] = (f32x2){bflo(qq), bfhi(qq)};
                    const f32x2 sg = {sigmoidf_(bflo(ff)), sigmoidf_(bfhi(ff))};
                    const f32x2 f = lb2 + (1.0f - lb2) * sg;
                    kv[j] = 1.0f - f; run = run * f; cum[j] = run;
                }
                *(LAS f32x2*)(TOT + seg * 128 + c0) = run;
            }
            __syncthreads();
            {
                f32x2 pre = {1.f, 1.f}, blast = {1.f, 1.f};
#pragma unroll
                for (int sgm = 0; sgm < 8; ++sgm) {
                    const f32x2 t = *(const LAS f32x2*)(TOT + sgm * 128 + c0);
                    if (sgm < seg) pre = pre * t;
                    blast = blast * t;
                }
                if (seg == 0) *(LAS f32x2*)(EB + c0) = blast;
                f32x2 kd[8];
#pragma unroll
                for (int j = 0; j < 8; ++j) {
                    const int tau = seg * 8 + j; const f32x2 cp = pre * cum[j]; const f32x2 icp = {__builtin_amdgcn_rcpf(cp.x), __builtin_amdgcn_rcpf(cp.y)};
                    const f32x2 a = qv[j] * cp, b = kv[j] * icp;
                    *(LAS unsigned*)(QS + tau * 136 + c0) = pk2(a.x, a.y);
                    *(LAS unsigned*)(KS + tau * 136 + c0) = pk2(b.x, b.y);
                    kd[j] = b * blast;
                }
                u32x4 k0, k1; k0.x = pk2(kd[0].x, kd[1].x); k0.y = pk2(kd[2].x, kd[3].x); k0.z = pk2(kd[4].x, kd[5].x); k0.w = pk2(kd[6].x, kd[7].x);
                k1.x = pk2(kd[0].y, kd[1].y); k1.y = pk2(kd[2].y, kd[3].y); k1.z = pk2(kd[4].y, kd[5].y); k1.w = pk2(kd[6].y, kd[7].y);
                *(LAS u32x4*)(KDT + c0 * 72 + seg * 8) = k0; *(LAS u32x4*)(KDT + (c0 + 1) * 72 + seg * 8) = k1;
            }
            __syncthreads();
            {
                const int dt = w & 3, tt = w >> 2;
                f32x16 oacc;
#pragma unroll
                for (int i = 0; i < 16; ++i) oacc[i] = 0.f;
                bf16x8 qb[8];
#pragma unroll
                for (int s = 0; s < 8; ++s) qb[s] = *(const LAS bf16x8*)(QS + (32 * tt + r) * 136 + 16 * s + 8 * h);
#pragma unroll
                for (int st = 0; st < 2; ++st) {
                    if (st <= tt) {
                        f32x16 x;
#pragma unroll
                        for (int i = 0; i < 16; ++i) x[i] = 0.f;
                        bf16x8 ka[8];
#pragma unroll
                        for (int s = 0; s < 8; ++s) ka[s] = *(const LAS bf16x8*)(KS + (32 * st + r) * 136 + 16 * s + 8 * h);
                        __builtin_amdgcn_sched_barrier(0);
#pragma unroll
                        for (int s = 0; s < 8; ++s) x = MFMA32(ka[s], qb[s], x);
                        if (st == tt) {
#pragma unroll
                            for (int i = 0; i < 16; ++i) if (crow(i, h) > r) x[i] = 0.f;
                        }
#pragma unroll
                        for (int s = 0; s < 2; ++s) {
                            u32x4 pw; pw.x = pk2(x[8 * s], x[8 * s + 1]); pw.y = pk2(x[8 * s + 2], x[8 * s + 3]); pw.z = pk2(x[8 * s + 4], x[8 * s + 5]); pw.w = pk2(x[8 * s + 6], x[8 * s + 7]);
                            const LAS bf16_t* vb = VR + (32 * st + 16 * s + 4 * h + ((lane & 15) >> 2)) * 160 + 32 * dt + 16 * ((lane >> 4) & 1) + 4 * (lane & 3);
                            const s16x4 lo = LDS_TR16(vb), hi = LDS_TR16(vb + 8 * 160);
                            oacc = MFMA32(__builtin_shufflevector(lo, hi, 0, 1, 2, 3, 4, 5, 6, 7), __builtin_bit_cast(bf16x8, pw), oacc);
                        }
                    }
                }
                {
                    bf16x8 sa[8];
#pragma unroll
                    for (int s = 0; s < 8; ++s) sa[s] = *(const LAS bf16x8*)(ST + (32 * dt + r) * 136 + 16 * s + 8 * h);
                    __builtin_amdgcn_sched_barrier(0);
#pragma unroll
                    for (int s = 0; s < 8; ++s) oacc = MFMA32(sa[s], qb[s], oacc);
                }
                LAS bf16_t* OLh = (LAS bf16_t*)(lds + 113152) + w * (32 * 40);
#pragma unroll
                for (int gq = 0; gq < 4; ++gq) {
                    u32x2 o; o.x = pk2(oacc[4 * gq], oacc[4 * gq + 1]); o.y = pk2(oacc[4 * gq + 2], oacc[4 * gq + 3]);
                    *(LAS u32x2*)(OLh + r * 40 + 8 * gq + 4 * h) = o;
                }
                asm volatile("s_waitcnt lgkmcnt(0)" ::: "memory");
                bf16_t* ob = dir ? (bf16_t*)(P.ws + OFF_OB) : (bf16_t*)(P.ws + OFF_AOUT);
#pragma unroll
                for (int k = 0; k < 2; ++k) {
                    const int p = lane + 64 * k, row = p >> 2, pc = p & 3;
                    const u32x4 v = *(const LAS u32x4*)(OLh + row * 40 + pc * 8);
                    *(u32x4*)(ob + (size_t)grow(ci, 32 * tt + row) * 2048 + hd * 128 + 32 * dt + pc * 8) = v;
                }
            }
            {
                const int ct = w >> 1;
#pragma unroll
                for (int i = 0; i < 16; ++i) { const float e = EB[32 * ct + crow(i, h)]; sacc[0][i] *= e; sacc[1][i] *= e; }
#pragma unroll
                for (int s = 0; s < 4; ++s) {
                    const bf16x8 a = *(const LAS bf16x8*)(KDT + (32 * ct + r) * 72 + 16 * s + 8 * h);
#pragma unroll
                    for (int x = 0; x < 2; ++x) {
                        const LAS bf16_t* vb = VR + (16 * s + 8 * h + ((lane & 15) >> 2)) * 160 + 32 * (2 * (w & 1) + x) + 16 * ((lane >> 4) & 1) + 4 * (lane & 3);
                        const s16x4 blo = LDS_TR16(vb), bhi = LDS_TR16(vb + 4 * 160);
                        const bf16x8 b = __builtin_shufflevector(blo, bhi, 0, 1, 2, 3, 4, 5, 6, 7);
                        sacc[x] = MFMA32(a, b, sacc[x]);
                    }
                }
            }
            if (ln_do) ln_row_finish(P, lnl, lnb0, ln_rl, lane, lnv);
        }
        __syncthreads();
    }
}

DI void phase_hgcombine(PRef P) {
    const bf16_t* PZ = (const bf16_t*)(P.ws + OFF_PZ);
    bf16_t* AO = (bf16_t*)(P.ws + OFF_AOUT);
    const bf16_t* OB = (const bf16_t*)(P.ws + OFF_OB);
    const float* gn = P.in[IN_HGNG];
    const size_t GT = (size_t)gridDim.x * 512, NIT = (size_t)CHR * 256;
    for (size_t i0 = (size_t)blockIdx.x * 512 + opaque_tid(); i0 < NIT; i0 += 4 * GT) {
        u32x4 a[4], b[4], z[4];
#pragma unroll
        for (int k = 0; k < 4; ++k) {
            const size_t i = i0 + k * GT;
            if (i < NIT) { const int row = (int)(i >> 8), c = (int)(i & 255) * 8;
                a[k] = *(const u32x4*)(AO + (size_t)row * 2048 + c); b[k] = *(const u32x4*)(OB + (size_t)row * 2048 + c); z[k] = *(const u32x4*)(PZ + (size_t)row * 10240 + 8192 + c); }
            else { a[k] = (u32x4){0u, 0u, 0u, 0u}; b[k] = a[k]; z[k] = a[k]; }
        }
#pragma unroll
        for (int k = 0; k < 4; ++k) {
            const size_t i = i0 + k * GT;
            const int row = (int)(i >> 8), c = (int)(i & 255) * 8;
            float o[8];
            o[0] = bflo(a[k].x) + bflo(b[k].x); o[1] = bfhi(a[k].x) + bfhi(b[k].x); o[2] = bflo(a[k].y) + bflo(b[k].y); o[3] = bfhi(a[k].y) + bfhi(b[k].y);
            o[4] = bflo(a[k].z) + bflo(b[k].z); o[5] = bfhi(a[k].z) + bfhi(b[k].z); o[6] = bflo(a[k].w) + bflo(b[k].w); o[7] = bfhi(a[k].w) + bfhi(b[k].w);
            float ss = 0.f;
#pragma unroll
            for (int j = 0; j < 8; ++j) ss += o[j] * o[j];
            ss += __shfl_xor(ss, 1); ss += __shfl_xor(ss, 2); ss += __shfl_xor(ss, 4); ss += __shfl_xor(ss, 8);
            if (i < NIT) {
                const float rs = rsqrtf(ss * (1.0f / 128.0f) + 1e-5f);
                const f32x4 g0 = *(const f32x4*)(gn + c), g1 = *(const f32x4*)(gn + c + 4);
                const float zz[8] = {bflo(z[k].x), bfhi(z[k].x), bflo(z[k].y), bfhi(z[k].y), bflo(z[k].z), bfhi(z[k].z), bflo(z[k].w), bfhi(z[k].w)};
                float q[8];
#pragma unroll
                for (int j = 0; j < 8; ++j) q[j] = o[j] * rs * (j < 4 ? g0[j] : g1[j - 4]) * siluf_(zz[j]);
                u32x4 wv; wv.x = pk2(q[0], q[1]); wv.y = pk2(q[2], q[3]); wv.z = pk2(q[4], q[5]); wv.w = pk2(q[6], q[7]);
                *(u32x4*)(AO + (size_t)row * 2048 + c) = wv;
            }
        }
    }
}

#define XB_TMO      128
#define XB_XCNT(j)  (256  + 64 * (j))
#define XB_XSUB(j)  (1280 + 64 * (j))
#define XB_XGEN(j)  (2304 + 64 * (j))
#define XB_TOP      3328
#define XB_TOPGEN   3392
#define XCD_BAR_WORDS 3456
#define XB_SPIN_CAP (1u << 18)
DI unsigned xb_ld(unsigned* p) { return __hip_atomic_load(p, __ATOMIC_RELAXED, __HIP_MEMORY_SCOPE_AGENT); }
DI unsigned xb_add(unsigned* p, unsigned v) { return __hip_atomic_fetch_add(p, v, __ATOMIC_RELAXED, __HIP_MEMORY_SCOPE_AGENT); }
DI unsigned xb_xcc_id() { return (unsigned)__builtin_amdgcn_s_getreg((3 << 11) | 20) & 0xFu; }
#define XB_SPIN(cond, bar) do { unsigned _sp = 0; while (cond) { __builtin_amdgcn_s_sleep(1); \
    if ((++_sp & 255u) == 0u) { if (xb_ld(&(bar)[XB_TMO])) break; if (_sp > XB_SPIN_CAP) { atomicAdd(&(bar)[XB_TMO], 1u); break; } } } } while (0)
struct XcdBarrier { unsigned* bar; unsigned x; volatile LAS unsigned* st; };
DI XcdBarrier xcd_barrier_post(unsigned* bar, volatile LAS unsigned* st) {
    XcdBarrier b; b.bar = bar; b.x = xb_xcc_id(); b.st = st;
    if (threadIdx.x == 0) (void)xb_add(&bar[XB_XCNT(b.x)], 1u);
    return b;
}
DI void xcd_barrier_complete(unsigned* bar, unsigned x, unsigned& nloc, unsigned& nx) {
    const unsigned G = gridDim.x * gridDim.y * gridDim.z;
    unsigned sum, cnt, mine, sp = 0u;
    for (;;) {
        sum = 0u; cnt = 0u; mine = 0u;
#pragma unroll
        for (unsigned j = 0; j < 16; ++j) { const unsigned c = xb_ld(&bar[XB_XCNT(j)]); sum += c; cnt += (c > 0u) ? 1u : 0u; mine = (j == x) ? c : mine; }
        if (sum == G) break;
        __builtin_amdgcn_s_sleep(1);
        if ((++sp & 255u) == 0u) { if (xb_ld(&bar[XB_TMO])) break; if (sp > XB_SPIN_CAP) { atomicAdd(&bar[XB_TMO], 1u); break; } }
    }
    nloc = mine > 0u ? mine : 1u; nx = cnt > 0u ? cnt : 1u;
}
DI void xcd_barrier(unsigned* bar_, volatile LAS unsigned* st_) {
    XcdBarrier b; b.bar = bar_; b.x = xb_xcc_id(); b.st = st_;
    asm volatile("s_waitcnt vmcnt(0)" ::: "memory");
    __syncthreads();
    if (threadIdx.x == 0) {
        unsigned* bar = b.bar;
        __builtin_amdgcn_s_waitcnt(0);
        unsigned nloc = b.st[0], nx = b.st[1];
        if (nloc == 0u) { xcd_barrier_complete(bar, b.x, nloc, nx); b.st[0] = nloc; b.st[1] = nx; }
        const unsigned old = xb_add(&bar[XB_XSUB(b.x)], 1u);
        const unsigned gen = old / nloc;
        if (old + 1u == (gen + 1u) * nloc) {
            __builtin_amdgcn_fence(__ATOMIC_RELEASE, "agent");
            asm volatile("s_waitcnt vmcnt(0)" ::: "memory");
            const unsigned og = xb_add(&bar[XB_TOP], 1u);
            const unsigned tg = og / nx;
            if (og + 1u == (tg + 1u) * nx) xb_add(&bar[XB_TOPGEN], 1u);
            else XB_SPIN(xb_ld(&bar[XB_TOPGEN]) == tg, bar);
            __builtin_amdgcn_fence(__ATOMIC_ACQUIRE, "agent");
            xb_add(&bar[XB_XGEN(b.x)], 1u);
            asm volatile("s_waitcnt vmcnt(0)" ::: "memory");
        } else {
            XB_SPIN(xb_ld(&bar[XB_XGEN(b.x)]) == gen, bar);
            __builtin_amdgcn_fence(__ATOMIC_ACQUIRE, "agent");
            asm volatile("s_waitcnt vmcnt(0)" ::: "memory");
        }
    }
    __syncthreads();
}

DI void stage_params(int t, int& layer, int& b0, int& nb) {
    asm volatile("" : "+s"(t));
    if (t < 2) { layer = 0; nb = 16; b0 = 16 * t; } else if (t < 6) { layer = 1; nb = 8; b0 = 8 * (t - 2); } else if (t < 10) { layer = 2; nb = 8; b0 = 8 * (t - 6); } else { layer = 3; nb = 16; b0 = 16 * (t - 10); }
}
__global__ void __launch_bounds__(512, 2) mega(Params P) {
    extern __shared__ __attribute__((aligned(16))) unsigned char lds_raw[];
    LAS unsigned char* lds = (LAS unsigned char*)lds_raw;
    cg::grid_group grid = cg::this_grid();
    const int G = gridDim.x, c = blockIdx.x;
    const __attribute__((address_space(4))) Params* kp = (const __attribute__((address_space(4))) Params*)__builtin_amdgcn_kernarg_segment_ptr();
#define PK (*({ const __attribute__((address_space(4))) Params* _p = kp; asm volatile("" : "+s"(_p)); _p; }))
    unsigned char* ws = PK.ws;
    bf16_t* Hb = (bf16_t*)(ws + OFF_H);
    bf16_t* PZ = (bf16_t*)(ws + OFF_PZ);
    bf16_t* AO = (bf16_t*)(ws + OFF_AOUT);
    const float* mods = (const float*)(ws + OFF_MODS);

    volatile LAS unsigned* bst = (volatile LAS unsigned*)(lds + LDS_BYTES - 16);
    if (threadIdx.x == 0) { bst[0] = 0u; bst[1] = 0u; }
    __syncthreads();
    (void)xcd_barrier_post((unsigned*)(PK.ws + OFF_BAR), bst);
#define GRID_BARRIER() xcd_barrier((unsigned*)(PK.ws + OFF_BAR), (volatile LAS unsigned*)(lds + LDS_BYTES - 16))
    phase_prologue(PK, lds);
    grid.sync();
    phase_modulate0(PK);
    GRID_BARRIER();
    constexpr int NSTAGE = 12;
#pragma unroll 1
    for (int s = 0; s <= NSTAGE; ++s) {
        int layer, b0, nb, pl, pb0, pnb;
        { const int t = s; if (t < 2) { layer = 0; nb = 16; b0 = 16 * t; } else if (t < 6) { layer = 1; nb = 8; b0 = 8 * (t - 2); } else if (t < 10) { layer = 2; nb = 8; b0 = 8 * (t - 6); } else { layer = 3; nb = 16; b0 = 16 * (t - 10); } }
        { const int t = s - 1; if (t < 2) { pl = 0; pnb = 16; pb0 = 16 * t; } else if (t < 6) { pl = 1; pnb = 8; pb0 = 8 * (t - 2); } else if (t < 10) { pl = 2; pnb = 8; pb0 = 8 * (t - 6); } else { pl = 3; pnb = 16; pb0 = 16 * (t - 10); } }
        const int kind = layer % 3;
        pg8::Sched S;
        int u2 = 0;
        if (s >= 1) {
            pg8::Gemm g{AO, (const bf16_t*)(ws + OFF_WT_OUT) + (size_t)pl * 1024 * 2048, 2048, 2048, 2048, 0, 0};
            Epi<EP_RES> e{};
            e.xin_lat = pl == 0 ? PK.in[IN_X] : PK.out; e.xin_ctx = pl == 0 ? PK.in[IN_CTX] : (const float*)(ws + OFF_XCTX);
            e.xout_lat = PK.out; e.xout_ctx = (float*)(ws + OFF_XCTX); e.gate = mods + (size_t)pl * 33 * 3072 + 2048; e.chunk = pb0; e.alpha = 1.681792830507429f;
            if (pl == 3) { S.init(pnb * 8, 4, 1, G, c, 1); u2 = pnb * 32; } else { S.init(pnb * 9, 4, 1, G, c, 0); u2 = pnb * 36; }
            pg8::gemm_phase(lds, g, S, e);
        }
        if (s < NSTAGE) {
            const bf16_t* Hc = Hb + (size_t)b0 * TPB * D;
            const int nN = kind == 0 ? 20 : (kind == 1 ? 16 : 40);
            const int u1 = nb * 9 * nN, base = u2 / G, rem = u2 % G, cmax = (2 * u2 + u1 + G - 1) / G;
            int R = cmax - 2 * (base + 1); if (R < 0) R = 0;
            if (kind == 0) {
                const int aj = layer / 3;
                pg8::Gemm g{Hc, (const bf16_t*)(ws + OFF_WT_ATT) + (size_t)aj * 5120 * 1024, 1024, 1024, 1024, 0, 0};
                Epi<EP_ROPE> e{}; e.O = PZ; e.ldc = 5120; e.rope = (const float*)(ws + OFF_ROPE);
                if (layer == 3) {
                    const int u1l = nb * 8 * nN, cm = (2 * u2 + u1l + G - 1) / G; int Rl = cm - 2 * (u2 / G + 1); if (Rl < 0) Rl = 0;
                    S.init(nb * 8, nN, 1, G, c, 1, Rl, rem); pg8::gemm_phase(lds, g, S, e);
                    S.init(nb, 4, 1, G, c - G / 2, 2); S.pn0 = 8; pg8::gemm_phase(lds, g, S, e);
                } else { S.init(nb * 9, nN, 1, G, c, 0, R, rem); pg8::gemm_phase(lds, g, S, e); }
            } else if (kind == 1) {
                pg8::Gemm g{Hc, (const bf16_t*)(ws + OFF_WT_S5), 1024, 1024, 1024, 0, 0};
                Epi<EP_S5IN> e{}; e.O = PZ; e.ldc = 4096; e.UH = (bf16_t*)(ws + OFF_UH);
                S.init(nb * 9, nN, 1, G, c, 0, R, rem); pg8::gemm_phase(lds, g, S, e);
            } else {
                pg8::Gemm g{Hc, (const bf16_t*)(ws + OFF_WT_HG), 1024, 1024, 1024, 0, 0};
                Epi<EP_PLAIN> e{}; e.O = PZ; e.ldc = 10240;
                S.init(nb * 9, nN, 1, G, c, 0, R, rem); pg8::gemm_phase(lds, g, S, e);
            }
        }
        GRID_BARRIER();
        if (s >= 1 && !(s < NSTAGE && (kind == 1 || kind == 2))) { int l2, b2, n2; stage_params(s - 1, l2, b2, n2); phase_ln(PK, l2, b2, n2); }
        if (s < NSTAGE) {
            if (kind == 0) {
                phase_attn(PK, lds, layer / 3, layer == 3, nb);
            } else if (kind == 1) {
                { pg8::Gemm g{(const bf16_t*)(ws + OFF_UH), (const bf16_t*)(ws + OFF_BT1), 512, 256, 256, 1280L * 512, 256L * 256};
                  Epi<EP_PLAIN> e{}; e.O = (bf16_t*)(ws + OFF_HLOC); e.zsC = 1280L * 256; e.ldc = 256;
                  S.init(5, 1, 128, G, c, 0); pg8::gemm_phase(lds, g, S, e); }
                GRID_BARRIER();
                phase_s5scan(PK);
                GRID_BARRIER();
                { pg8::Gemm g{(const bf16_t*)(ws + OFF_UH), (const bf16_t*)(ws + OFF_BT3), 512, 512, 512, 1280L * 512, 256L * 512};
                  Epi<EP_S5OUT> e{}; e.O = PZ;
                  S.init(5, 1, 128, G, c, 0); pg8::gemm_phase(lds, g, S, e); }
                GRID_BARRIER();
                { pg8::Gemm g{PZ, (const bf16_t*)(ws + OFF_WT_GLU), 4096, 2048, 2048, 0, 0};
                  Epi<EP_GLU> e{}; e.O = AO; e.ldc = 2048; e.PZ = PZ; e.bias = PK.in[IN_GLUB];
                  const int heavy = (72 * 8) % G;
                  if (s >= 1) { int l2, b2, n2; stage_params(s - 1, l2, b2, n2); if (heavy > 0 && heavy < G) phase_ln(PK, l2, b2, n2, heavy, G - heavy); else phase_ln(PK, l2, b2, n2); }
                  S.init(72, 8, 1, G, c, 0); pg8::gemm_phase(lds, g, S, e); }
            } else {
                { int l2, b2, n2; stage_params(s - 1, l2, b2, n2);
                  const bool emb = (G * 8 * 9 == n2 * TPB);
                  if (s >= 1 && !emb) phase_ln(PK, l2, b2, n2);
                  phase_hgrn(PK, lds, layer, (s >= 1 && emb) ? l2 : -1, b2, n2); }
                GRID_BARRIER();
                phase_hgcombine(PK);
            }
            GRID_BARRIER();
        }
    }
}

extern "C" void kernel_launch(void* const* d_in, const int* in_sizes, int n_in, void* d_out, int out_size,
                              void* d_ws, size_t ws_size, hipStream_t stream) {
    static int grid_blocks = 0;
    if (!grid_blocks) {
        if (n_in != 25 || ws_size < WS_END) { fprintf(stderr, "kernel_launch: unexpected inputs (n_in %d, ws %zu < %zu); nothing launched\n", n_in, ws_size, (size_t)WS_END); grid_blocks = -1; return; }
        int dev = 0, cus = 0, per_cu = 0;
        (void)hipGetDevice(&dev);
        (void)hipDeviceGetAttribute(&cus, hipDeviceAttributeMultiprocessorCount, dev);
        (void)hipFuncSetAttribute((const void*)mega, hipFuncAttributeMaxDynamicSharedMemorySize, LDS_BYTES);
        (void)hipOccupancyMaxActiveBlocksPerMultiprocessor(&per_cu, (const void*)mega, 512, LDS_BYTES);
        if (per_cu < 1) per_cu = 1;
        grid_blocks = cus * per_cu;
    }
    if (grid_blocks < 0) return;
    Params p{};
    for (int i = 0; i < 25; ++i) p.in[i] = (const float*)d_in[i];
    p.out = (float*)d_out; p.ws = (unsigned char*)d_ws;
    (void)hipMemsetAsync((unsigned char*)d_ws + OFF_BAR, 0, 16384, stream);
    void* args[] = {&p};
    hipError_t e = hipLaunchCooperativeKernel((const void*)mega, dim3(grid_blocks), dim3(512), args, LDS_BYTES, stream);
    if (e != hipSuccess) fprintf(stderr, "cooperative launch failed: %s (grid %d)\n", hipGetErrorString(e), grid_blocks);
}
```
